# Optimizing an MI355X kernel written in HIP

```python
import jax, jax.numpy as jnp
from jax import lax
import numpy as np

D_MODEL = 1024
BATCH = 1
SEQ = 16384
DEPTH = 4
DEC_BATCH = 8
DEC_SEQ = 4096
PAST_LEN = 128

N_META = 16
EPS = 1e-6
CONV_WIDTH = 3 * D_MODEL // 8
CONV_HEADS = 6
POOL_GROUPS = 4
POOL_WINDOWS = (2, 4, 8, 16)
POOL_WIDTH = 3 * D_MODEL // 8
POOL_GROUP_DIM = POOL_WIDTH // POOL_GROUPS
FOURIER_HEADS = 4
FOURIER_WIDTH = D_MODEL - CONV_WIDTH - POOL_WIDTH
FOURIER_HEAD_DIM = FOURIER_WIDTH // FOURIER_HEADS
MIX_WIDTH = CONV_WIDTH + POOL_WIDTH + FOURIER_WIDTH
IN_WIDTH = 3 * CONV_WIDTH + POOL_WIDTH + FOURIER_WIDTH
D_FF = -(-8 * D_MODEL // (3 * 256)) * 256

kernel_name = "hymba_conv_pool_fourier_encoder"


def _rms(x):
    xf = x.astype(jnp.float32)
    return xf * lax.rsqrt(jnp.mean(xf * xf, axis=-1, keepdims=True) + EPS)


def _rmsnorm(x, g):
    return (_rms(x) * g.astype(jnp.float32)).astype(x.dtype)


def _short_conv(u, w):
    up = jnp.pad(u, ((0, 0), (1, 1), (0, 0)))
    return up[:, :-2] * w[0] + up[:, 1:-1] * w[1] + up[:, 2:] * w[2]


def _centred_mean_minus_self(u, window):
    L = u.shape[1]
    left = window // 2
    right = window - 1 - left
    uf = u.astype(jnp.float32)
    cs = jnp.pad(jnp.cumsum(uf, axis=1), ((0, 0), (1, 0), (0, 0)))
    csp = jnp.pad(cs, ((0, 0), (left, right), (0, 0)), mode="edge")
    hi = csp[:, left + right + 1:left + right + 1 + L]
    lo = csp[:, :L]
    pos = jnp.arange(L)
    cnt = (jnp.minimum(pos + right, L - 1) - jnp.maximum(pos - left, 0) + 1).astype(jnp.float32)
    return ((hi - lo) / cnt[None, :, None] - uf).astype(u.dtype)


def _multiscale_pool(u, pool_w, pool_scale):
    outs = []
    for gi, win in enumerate(POOL_WINDOWS):
        ug = u[..., gi * POOL_GROUP_DIM:(gi + 1) * POOL_GROUP_DIM]
        outs.append(_centred_mean_minus_self(ug, win) @ pool_w[gi])
    return jnp.concatenate(outs, axis=-1) * pool_scale


def _fourier(u):
    B_, L, _ = u.shape
    uh = u.astype(jnp.float32).reshape(B_, L, FOURIER_HEADS, FOURIER_HEAD_DIM).transpose(0, 2, 1, 3)
    f = jnp.fft.fft2(uh, axes=(-2, -1), norm="ortho").real
    return f.transpose(0, 2, 1, 3).reshape(B_, L, FOURIER_WIDTH).astype(u.dtype)


def _layer(h, norm1_g, w_in, conv_w, pool_w, pool_scale, mix_g, w_out, norm2_g, w_gate_up, w_down):
    u = _rmsnorm(h, norm1_g)
    z = u @ w_in
    c0 = CONV_WIDTH
    xa, gb, gc = z[..., :c0], z[..., c0:2 * c0], z[..., 2 * c0:3 * c0]
    xp = z[..., 3 * c0:3 * c0 + POOL_WIDTH]
    xf = z[..., 3 * c0 + POOL_WIDTH:]
    a = gb * _short_conv(gc * xa, conv_w)
    p = _multiscale_pool(xp, pool_w, pool_scale)
    f = _fourier(xf)
    mix = jnp.concatenate([_rms(a), _rms(p), _rms(f)], axis=-1) * mix_g.astype(jnp.float32)
    h = h + mix.astype(h.dtype) @ w_out
    v = _rmsnorm(h, norm2_g)
    gu = v @ w_gate_up
    gate, up = gu[..., :D_FF], gu[..., D_FF:]
    return h + (jax.nn.silu(gate) * up) @ w_down


def _trunk(x, meta_tokens, norm1_g, w_in, conv_w, pool_w, pool_scale, mix_g, w_out, norm2_g, w_gate_up, w_down, final_g):
    B_ = x.shape[0]
    meta = jnp.broadcast_to(meta_tokens.astype(x.dtype)[None], (B_, N_META, D_MODEL))
    h = jnp.concatenate([meta, x], axis=1)
    for l in range(DEPTH):
        h = _layer(h, norm1_g[l], w_in[l], conv_w[l], pool_w[l], pool_scale[l], mix_g[l],
                   w_out[l], norm2_g[l], w_gate_up[l], w_down[l])
    return _rmsnorm(h, final_g)[:, N_META:]


def setup_inputs(seed: int = 0) -> dict:
    key = jax.random.key(seed)
    ks = jax.random.split(key, 16)
    f32 = jnp.float32
    nrm = lambda k, shape, s: jax.random.normal(k, shape, f32) * s
    return {
        "x_prompt": nrm(ks[0], (BATCH, SEQ, D_MODEL), 1.0),
        "x_sample": nrm(ks[1], (DEC_BATCH, DEC_SEQ, D_MODEL), 1.0),
        "meta_tokens": nrm(ks[2], (N_META, D_MODEL), 1.0),
        "norm1_g": 1.0 + nrm(ks[3], (DEPTH, D_MODEL), 0.02),
        "w_in": nrm(ks[4], (DEPTH, D_MODEL, IN_WIDTH), D_MODEL ** -0.5),
        "conv_w": nrm(ks[5], (DEPTH, 3, CONV_WIDTH), 3 ** -0.5),
        "pool_w": nrm(ks[6], (DEPTH, POOL_GROUPS, POOL_GROUP_DIM, POOL_GROUP_DIM), POOL_GROUP_DIM ** -0.5),
        "pool_scale": 1.0 + nrm(ks[7], (DEPTH, POOL_WIDTH), 0.1),
        "mix_g": 1.0 + nrm(ks[8], (DEPTH, MIX_WIDTH), 0.02),
        "w_out": nrm(ks[9], (DEPTH, MIX_WIDTH, D_MODEL), MIX_WIDTH ** -0.5),
        "norm2_g": 1.0 + nrm(ks[10], (DEPTH, D_MODEL), 0.02),
        "w_gate_up": nrm(ks[11], (DEPTH, D_MODEL, 2 * D_FF), D_MODEL ** -0.5),
        "w_down": nrm(ks[12], (DEPTH, D_FF, D_MODEL), D_FF ** -0.5),
        "final_g": 1.0 + nrm(ks[13], (D_MODEL,), 0.02),
    }


def reference(x_prompt, x_sample, meta_tokens, norm1_g, w_in, conv_w, pool_w, pool_scale, mix_g,
              w_out, norm2_g, w_gate_up, w_down, final_g):
    y_prompt = _trunk(x_prompt, meta_tokens, norm1_g, w_in, conv_w, pool_w, pool_scale, mix_g,
                      w_out, norm2_g, w_gate_up, w_down, final_g)
    y_sample = _trunk(x_sample, meta_tokens, norm1_g, w_in, conv_w, pool_w, pool_scale, mix_g,
                      w_out, norm2_g, w_gate_up, w_down, final_g)
    return (y_prompt, y_sample)
```

```cpp
#include <hip/hip_runtime.h>
#include <hip/hip_cooperative_groups.h>
#include <cstdio>
#include <cstdint>
namespace cg = cooperative_groups;

#ifndef MEGA
#define MEGA 0
#endif

#define LAS __attribute__((address_space(3)))
#define DEV __device__ __forceinline__
typedef unsigned short bf16_t;
typedef short bf16x8 __attribute__((ext_vector_type(8)));
typedef float f32x4 __attribute__((ext_vector_type(4)));
typedef float f32x2 __attribute__((ext_vector_type(2)));
typedef unsigned u32x4 __attribute__((ext_vector_type(4)));
typedef unsigned u32x2 __attribute__((ext_vector_type(2)));

constexpr int D = 1024, NZ = 2048, DFF = 2816, NGU = 5632, DEPTH = 4, NIN0 = 1792;
constexpr int TX = 49152, TMETA = 144, T = TX + TMETA, TP = TX + 256;
constexpr int LP = 16400, LS = 4112, L2P = 1025, L2S = 257;
constexpr int KHP = 1088, KHS = 320, KP = 2 * KHP, KS = 2 * KHS, MPP = 1280, MPS = 512;
constexpr int NCP = 4096, NCS = 32768;
constexpr int NGROUPS = 3081;
constexpr float EPS = 1e-6f;
constexpr int LDS_BYTES = 131072;
constexpr int NT = 512;

constexpr size_t al(size_t x) { return (x + 255) & ~size_t(255); }
constexpr size_t WS_W1 = 0;
constexpr size_t WS_W2 = WS_W1 + al((size_t)DEPTH * NZ * D * 2);
constexpr size_t WS_W3 = WS_W2 + al((size_t)DEPTH * D * D * 2);
constexpr size_t WS_W4 = WS_W3 + al((size_t)DEPTH * NGU * D * 2);
constexpr size_t WS_PW = WS_W4 + al((size_t)DEPTH * D * DFF * 2);
constexpr size_t WS_DP = WS_PW + al((size_t)DEPTH * 4 * 96 * 96 * 2);
constexpr size_t WS_DS = WS_DP + al((size_t)MPP * KP * 2);
constexpr size_t WS_TWP = WS_DS + al((size_t)MPS * KS * 2);
constexpr size_t WS_TWS = WS_TWP + al((size_t)16 * KHP * 8);
constexpr size_t WS_SS1 = WS_TWS + al((size_t)16 * KHS * 8);
constexpr size_t WS_SS2 = WS_SS1 + al((size_t)TP * 4 * 4);
constexpr size_t WS_HM = WS_SS2 + al((size_t)TP * 4 * 4);
constexpr size_t WS_HB = WS_HM + al((size_t)256 * D * 4);
constexpr size_t WS_Z = WS_HB + al((size_t)TP * D * 2);
constexpr size_t WS_MIX = WS_Z + al((size_t)TP * NZ * 2);
constexpr size_t WS_END = WS_MIX + al((size_t)TP * D * 2);
constexpr size_t WS_WBP = WS_HB;
constexpr size_t WS_WBS = WS_HB + (size_t)KP * NCP * 2;
constexpr size_t WS_ACT = WS_Z;
static_assert((size_t)KP * NCP * 2 + (size_t)KS * NCS * 2 <= (size_t)TP * D * 2, "WB overlay");
static_assert((size_t)TP * DFF * 2 <= (WS_END - WS_Z), "ACT overlay");

struct Params {
    const float *x_prompt, *x_sample, *meta, *norm1_g, *w_in, *conv_w, *pool_w, *pool_scale, *mix_g, *w_out, *norm2_g, *w_gate_up, *w_down, *final_g;
    float* out; unsigned char* ws;
};

DEV unsigned cvt_pk_bf16(float lo, float hi) { unsigned r; asm("v_cvt_pk_bf16_f32 %0, %1, %2" : "=v"(r) : "v"(lo), "v"(hi)); return r; }
DEV float bflo(unsigned w) { return __uint_as_float(w << 16); }
DEV float bfhi(unsigned w) { return __uint_as_float(w & 0xffff0000u); }
DEV float bf2f(bf16_t v) { return __uint_as_float((unsigned)v << 16); }

DEV int seq_xbase(int s) { return s == 0 ? 0 : 16384 + 4096 * (s - 1); }
DEV int rowof(int s, int p) { return p < 16 ? TX + 16 * s + p : seq_xbase(s) + p - 16; }

DEV int swz_off(int fr, int fq) { int ob = fr * 64 + fq * 16; return ob ^ (((ob >> 9) & 1) << 5); }
DEV void stage_rc(int b, int& R, int& C) { int st = b >> 10, sb = b & 1023, swz = sb ^ (((sb >> 9) & 1) << 5); R = (st >> 1) * 16 + (swz >> 6); C = (st & 1) * 32 + ((swz & 63) >> 1); }

#define GLDS(g, l) __builtin_amdgcn_global_load_lds((const unsigned*)(g), (LAS unsigned*)(l), 16, 0, 0)
#define WAIT_V(n) asm volatile("s_waitcnt vmcnt(" #n ")" ::: "memory")
#define WAIT_L(n) asm volatile("s_waitcnt lgkmcnt(" #n ")" ::: "memory")
#define BAR __builtin_amdgcn_s_barrier()
#define SCHED __builtin_amdgcn_sched_barrier(0)

template <int BMODE, class Epi>
DEV void gemm_tile(LAS unsigned char* lds, const bf16_t* __restrict__ A, int lda, const bf16_t* __restrict__ B, int ldb, int K, int brow, int bcol, const Epi& epi) {
    int tid = threadIdx.x; asm volatile("" : "+v"(tid));
    const int wid = tid >> 6, lane = tid & 63, wr = wid >> 2, wc = wid & 3, fr = lane & 15, fq = lane >> 4;
    int r0, c0; stage_rc(tid * 16, r0, c0);
    const unsigned voa0 = (unsigned)(r0 * lda + c0) * 2u, voa1 = voa0 + (unsigned)(64 * lda) * 2u;
    const char* Ab = (const char*)(A + (size_t)brow * lda);
    const size_t ahalf = (size_t)128 * lda * 2;
    unsigned vob0, vob1; const char* Bb; size_t bks, bhalf;
    if (BMODE == 0) { vob0 = (unsigned)(r0 * ldb + c0) * 2u; vob1 = vob0 + (unsigned)(64 * ldb) * 2u; Bb = (const char*)(B + (size_t)bcol * ldb); bks = 128; bhalf = (size_t)128 * ldb * 2; }
    else { vob0 = (unsigned)((c0 >> 3) * ldb + r0) * 16u; vob1 = vob0 + 64u * 16u; Bb = (const char*)(B + (size_t)bcol * 8); bks = (size_t)ldb * 128; bhalf = 128 * 16; }
    LAS unsigned char* lw = lds + tid * 16;
    const int sw = swz_off(fr, fq);
    LAS unsigned char* la = lds + wr * 8192 + sw;
    LAS unsigned char* lb = lds + 65536 + wc * 4096 + sw;

#define STAGE_A(b, h, kt) do { const char* _g = Ab + (h) * ahalf + (size_t)(kt) * 128; LAS unsigned char* _l = lw + ((b) * 2 + (h)) * 16384; GLDS(_g + voa0, _l); GLDS(_g + voa1, _l + 8192); } while (0)
#define STAGE_B(b, h, kt) do { const char* _g = Bb + (h) * bhalf + (size_t)(kt) * bks; LAS unsigned char* _l = lw + 65536 + ((b) * 2 + (h)) * 16384; GLDS(_g + vob0, _l); GLDS(_g + vob1, _l + 8192); } while (0)
#define LDA(dst, b, h) _Pragma("unroll") for (int m = 0; m < 4; ++m) _Pragma("unroll") for (int k = 0; k < 2; ++k) dst[m][k] = *(const LAS bf16x8*)(la + ((b) * 2 + (h)) * 16384 + m * 2048 + k * 1024)
#define LDB(dst, b, h) _Pragma("unroll") for (int n = 0; n < 2; ++n) _Pragma("unroll") for (int k = 0; k < 2; ++k) dst[n][k] = *(const LAS bf16x8*)(lb + ((b) * 2 + (h)) * 16384 + n * 2048 + k * 1024)
#define MMA(ai, bj, Af, Bf) do { __builtin_amdgcn_s_setprio(1); \
    _Pragma("unroll") for (int m = 0; m < 4; ++m) _Pragma("unroll") for (int n = 0; n < 2; ++n) _Pragma("unroll") for (int k = 0; k < 2; ++k) \
        acc[ai][bj][m][n] = __builtin_amdgcn_mfma_f32_16x16x32_bf16(Bf[n][k], Af[m][k], acc[ai][bj][m][n], 0, 0, 0); \
    __builtin_amdgcn_s_setprio(0); } while (0)

    f32x4 acc[2][2][4][2];
#pragma unroll
    for (int a = 0; a < 2; ++a)
#pragma unroll
        for (int b = 0; b < 2; ++b)
#pragma unroll
            for (int m = 0; m < 4; ++m)
#pragma unroll
                for (int n = 0; n < 2; ++n) acc[a][b][m][n] = (f32x4){0.f, 0.f, 0.f, 0.f};
    bf16x8 At[4][2], B0[2][2], B1[2][2];
    const int nt = K / 64;
    STAGE_B(0, 0, 0); STAGE_A(0, 0, 0); STAGE_B(0, 1, 0); STAGE_A(0, 1, 0);
    if (wr == 1) BAR;
    WAIT_V(4); BAR;
    STAGE_B(1, 0, 1); STAGE_A(1, 0, 1); STAGE_B(1, 1, 1);
    WAIT_V(6); BAR;
    for (int t = 0; t < nt - 2; t += 2) {
        LDB(B0, 0, 0); SCHED; LDA(At, 0, 0); STAGE_A(1, 1, t + 1);
        WAIT_L(8); BAR; WAIT_L(0); MMA(0, 0, At, B0); BAR; SCHED;
        LDB(B1, 0, 1); STAGE_B(0, 0, t + 2);
        BAR; WAIT_L(0); MMA(0, 1, At, B1); BAR;
        LDA(At, 0, 1); STAGE_A(0, 0, t + 2);
        BAR; WAIT_L(0); MMA(1, 0, At, B0); BAR; SCHED;
        STAGE_B(0, 1, t + 2);
        WAIT_V(6); BAR; MMA(1, 1, At, B1); BAR;
        LDB(B0, 1, 0); SCHED; LDA(At, 1, 0); STAGE_A(0, 1, t + 2);
        WAIT_L(8); BAR; WAIT_L(0); MMA(0, 0, At, B0); BAR; SCHED;
        LDB(B1, 1, 1); STAGE_B(1, 0, t + 3);
        BAR; WAIT_L(0); MMA(0, 1, At, B1); BAR;
        LDA(At, 1, 1); STAGE_A(1, 0, t + 3);
        BAR; WAIT_L(0); MMA(1, 0, At, B0); BAR; SCHED;
        STAGE_B(1, 1, t + 3);
        WAIT_V(6); BAR; MMA(1, 1, At, B1); BAR;
    }
    { LDB(B0, 0, 0); LDA(At, 0, 0); STAGE_A(1, 1, nt - 1);
      BAR; WAIT_L(0); MMA(0, 0, At, B0); BAR;
      LDB(B1, 0, 1); BAR; WAIT_L(0); MMA(0, 1, At, B1); BAR;
      LDA(At, 0, 1); WAIT_V(4); BAR; WAIT_L(0); MMA(1, 0, At, B0); MMA(1, 1, At, B1); BAR; }
    { LDB(B0, 1, 0); LDA(At, 1, 0); WAIT_V(2); BAR; WAIT_L(0); MMA(0, 0, At, B0); BAR;
      LDB(B1, 1, 1); WAIT_V(0); BAR; WAIT_L(0); MMA(0, 1, At, B1); BAR;
      LDA(At, 1, 1); BAR; WAIT_L(0); MMA(1, 0, At, B0); MMA(1, 1, At, B1); BAR; }
    if (wr == 0) BAR;
    epi(acc, brow, bcol, lds);
    __syncthreads();
#undef STAGE_A
#undef STAGE_B
#undef LDA
#undef LDB
#undef MMA
}

DEV void tile_map(int L, int nM, int nN, int& pm, int& pn) {
    const int nwg = nM * nN; int wgid = L;
    { const int q = nwg / 8, r = nwg % 8, xcd = wgid % 8, off = wgid / 8; wgid = (xcd < r ? xcd * (q + 1) : r * (q + 1) + (xcd - r) * q) + off; }
    const int nig = 8 * nN, gid = wgid / nig, fm = gid * 8, gsz = (nM - fm) < 8 ? (nM - fm) : 8;
    pm = fm + ((wgid % nig) % gsz); pn = (wgid % nig) / gsz;
}

#define EPI_IDS int tid = threadIdx.x; asm volatile("" : "+v"(tid)); const int wid = tid >> 6, lane = tid & 63, wr = wid >> 2, wc = wid & 3, fr = lane & 15, fq = lane >> 4; (void)wc; (void)fq; (void)fr; (void)wr;

DEV float row_rs(const float* ss, int row) { const f32x4 s4 = *(const f32x4*)(ss + (size_t)row * 4); return rsqrtf(((s4[0] + s4[1]) + (s4[2] + s4[3])) * (1.0f / 1024.0f) + EPS); }

struct Epi1 {
    bf16_t* z; const float* ss;
    DEV void operator()(f32x4 (&acc)[2][2][4][2], int brow, int bcol, LAS unsigned char*) const {
        EPI_IDS
#pragma unroll
        for (int ai = 0; ai < 2; ++ai)
#pragma unroll
            for (int m = 0; m < 4; ++m) {
                const int row = brow + ai * 128 + wr * 64 + m * 16 + fr;
                const float rs = row_rs(ss, row);
#pragma unroll
                for (int bj = 0; bj < 2; ++bj)
#pragma unroll
                    for (int n = 0; n < 2; ++n) {
                        const f32x4 v = acc[ai][bj][m][n] * rs;
                        u32x2 w; w.x = cvt_pk_bf16(v[0], v[1]); w.y = cvt_pk_bf16(v[2], v[3]);
                        *(u32x2*)(z + (size_t)row * NZ + bcol + bj * 128 + wc * 32 + n * 16 + fq * 4) = w;
                    }
            }
    }
};

struct EpiRes {
    float* hx; float* hm; bf16_t* hb; float* ssout;
    DEV void operator()(f32x4 (&acc)[2][2][4][2], int brow, int bcol, LAS unsigned char* lds) const {
        EPI_IDS
        float* hbase = brow < TX ? hx + (size_t)brow * D : hm + (size_t)(brow - TX) * D;
        LAS float* ex = (LAS float*)lds;
#pragma unroll
        for (int ai = 0; ai < 2; ++ai)
#pragma unroll
            for (int m = 0; m < 4; ++m) {
                const int lr = ai * 128 + wr * 64 + m * 16 + fr, row = brow + lr;
                const bool valid = row < T;
                float s = 0.f;
#pragma unroll
                for (int bj = 0; bj < 2; ++bj)
#pragma unroll
                    for (int n = 0; n < 2; ++n) {
                        const int col = bcol + bj * 128 + wc * 32 + n * 16 + fq * 4;
                        f32x4 v = acc[ai][bj][m][n];
                        if (valid) {
                            float* hp = hbase + (size_t)lr * D + col;
                            v += *(const f32x4*)hp;
                            *(f32x4*)hp = v;
                            u32x2 w; w.x = cvt_pk_bf16(v[0], v[1]); w.y = cvt_pk_bf16(v[2], v[3]);
                            *(u32x2*)(hb + (size_t)row * D + col) = w;
                        }
                        s += (v[0] * v[0] + v[1] * v[1]) + (v[2] * v[2] + v[3] * v[3]);
                    }
                s += __shfl_xor(s, 16); s += __shfl_xor(s, 32);
                if (fq == 0) ex[lr * 4 + wc] = s;
            }
        __syncthreads();
        if (tid < 256) { const f32x4 e = *(const LAS f32x4*)(ex + tid * 4); ssout[(size_t)(brow + tid) * 4 + (bcol >> 8)] = (e[0] + e[1]) + (e[2] + e[3]); }
    }
};

struct Epi3 {
    bf16_t* act; const float* ss;
    DEV void operator()(f32x4 (&acc)[2][2][4][2], int brow, int bcol, LAS unsigned char*) const {
        EPI_IDS
#pragma unroll
        for (int ai = 0; ai < 2; ++ai)
#pragma unroll
            for (int m = 0; m < 4; ++m) {
                const int row = brow + ai * 128 + wr * 64 + m * 16 + fr;
                const float rs = row_rs(ss, row);
#pragma unroll
                for (int bj = 0; bj < 2; ++bj) {
                    const int col = ((bcol >> 5) + bj * 4 + wc) * 16 + fq * 4;
                    const f32x4 g = acc[ai][bj][m][0] * rs, u = acc[ai][bj][m][1] * rs;
                    float o[4];
#pragma unroll
                    for (int j = 0; j < 4; ++j) o[j] = g[j] * __builtin_amdgcn_rcpf(1.0f + __expf(-g[j])) * u[j];
                    u32x2 w; w.x = cvt_pk_bf16(o[0], o[1]); w.y = cvt_pk_bf16(o[2], o[3]);
                    *(u32x2*)(act + (size_t)row * DFF + col) = w;
                }
            }
    }
};

struct EpiF {
    bf16_t* mix; int s, k1, L2;
    DEV void operator()(f32x4 (&acc)[2][2][4][2], int brow, int bcol, LAS unsigned char* lds) const {
        EPI_IDS
        LAS float* ex = (LAS float*)lds;
#pragma unroll
        for (int ai = 0; ai < 2; ++ai)
#pragma unroll
            for (int m = 0; m < 4; ++m) {
                const int lr = ai * 128 + wr * 64 + m * 16 + fr;
                float q = 0.f;
#pragma unroll
                for (int bj = 0; bj < 2; ++bj)
#pragma unroll
                    for (int n = 0; n < 2; ++n) { const f32x4 v = acc[ai][bj][m][n]; q += (v[0] * v[0] + v[1] * v[1]) + (v[2] * v[2] + v[3] * v[3]); }
                q += __shfl_xor(q, 16); q += __shfl_xor(q, 32);
                if (fq == 0) ex[lr * 4 + wc] = q;
            }
        __syncthreads();
#pragma unroll
        for (int ai = 0; ai < 2; ++ai)
#pragma unroll
            for (int m = 0; m < 4; ++m) {
                const int lr = ai * 128 + wr * 64 + m * 16 + fr, k2 = brow + lr;
                const f32x4 e = *(const LAS f32x4*)(ex + lr * 4);
                const float rs = rsqrtf(((e[0] + e[1]) + (e[2] + e[3])) * (1.0f / 256.0f) + EPS);
                if (k2 < L2) {
                    const int row = rowof(s, k1 + 16 * k2);
#pragma unroll
                    for (int bj = 0; bj < 2; ++bj)
#pragma unroll
                        for (int n = 0; n < 2; ++n) {
                            const f32x4 v = acc[ai][bj][m][n] * rs;
                            u32x2 w; w.x = cvt_pk_bf16(v[0], v[1]); w.y = cvt_pk_bf16(v[2], v[3]);
                            *(u32x2*)(mix + (size_t)row * D + 768 + bj * 128 + wc * 32 + n * 16 + fq * 4) = w;
                        }
                }
            }
    }
};

DEV u32x4 pack8(const float (&v)[8]) { u32x4 w; w.x = cvt_pk_bf16(v[0], v[1]); w.y = cvt_pk_bf16(v[2], v[3]); w.z = cvt_pk_bf16(v[4], v[5]); w.w = cvt_pk_bf16(v[6], v[7]); return w; }

DEV void phase_prologue(const Params& p, LAS unsigned char* lds) {
    unsigned char* ws = p.ws;
    int tid = threadIdx.x; asm volatile("" : "+v"(tid));
    const long gt = (long)blockIdx.x * NT + tid, gs = (long)gridDim.x * NT;
    LAS float* ctab = (LAS float*)lds;
    if (tid < 64) ctab[tid] = cospif((float)tid * (1.0f / 32.0f));
    __syncthreads();
    bf16_t* W1 = (bf16_t*)(ws + WS_W1); bf16_t* W2 = (bf16_t*)(ws + WS_W2); bf16_t* W3 = (bf16_t*)(ws + WS_W3); bf16_t* W4 = (bf16_t*)(ws + WS_W4);
    for (long i = gt; i < (long)DEPTH * 128 * 1536; i += gs) {
        const int n = (int)(i % 1536), k8 = (int)((i / 1536) % 128), l = (int)(i / (1536 * 128));
        float v[8];
#pragma unroll
        for (int j = 0; j < 8; ++j) { const int k = k8 * 8 + j; v[j] = p.w_in[((size_t)l * D + k) * NIN0 + n] * p.norm1_g[l * D + k]; }
        *(u32x4*)(W1 + ((size_t)l * NZ + n) * D + k8 * 8) = pack8(v);
    }
    for (long i = gt; i < (long)DEPTH * 128 * 512; i += gs) {
        const int nn = (int)(i % 512), k8 = (int)((i / 512) % 128), l = (int)(i / (512 * 128));
        const int part = nn >> 8, mm = nn & 255, hd = mm >> 6, m = mm & 63;
        float v[8];
#pragma unroll
        for (int j = 0; j < 8; ++j) {
            const int k = k8 * 8 + j;
            const float* src = p.w_in + ((size_t)l * D + k) * NIN0 + 1536 + hd * 64;
            float a = 0.f;
            for (int c = 0; c < 64; ++c) { const int jj = (m * c) & 63; const float cf = part == 0 ? ctab[jj] : -ctab[(jj - 16) & 63]; a += src[c] * cf; }
            v[j] = a * p.norm1_g[l * D + k];
        }
        *(u32x4*)(W1 + ((size_t)l * NZ + 1536 + nn) * D + k8 * 8) = pack8(v);
    }
    for (long i = gt; i < (long)DEPTH * 128 * 1024; i += gs) {
        const int n = (int)(i % 1024), k8 = (int)((i / 1024) % 128), l = (int)(i / (1024 * 128));
        float v[8];
#pragma unroll
        for (int j = 0; j < 8; ++j) { const int k = k8 * 8 + j; v[j] = p.w_out[((size_t)l * D + k) * D + n] * p.mix_g[l * D + k]; }
        *(u32x4*)(W2 + ((size_t)l * D + n) * D + k8 * 8) = pack8(v);
    }
    for (long i = gt; i < (long)DEPTH * 128 * NGU; i += gs) {
        const int n = (int)(i % NGU), k8 = (int)((i / NGU) % 128), l = (int)(i / ((long)NGU * 128));
        const int q = n >> 5, r = n & 31, col = r < 16 ? q * 16 + r : DFF + q * 16 + (r - 16);
        float v[8];
#pragma unroll
        for (int j = 0; j < 8; ++j) { const int k = k8 * 8 + j; v[j] = p.w_gate_up[((size_t)l * D + k) * NGU + col] * p.norm2_g[l * D + k]; }
        *(u32x4*)(W3 + ((size_t)l * NGU + n) * D + k8 * 8) = pack8(v);
    }
    for (long i = gt; i < (long)DEPTH * 352 * 1024; i += gs) {
        const int n = (int)(i % 1024), k8 = (int)((i / 1024) % 352), l = (int)(i / (1024 * 352));
        float v[8];
#pragma unroll
        for (int j = 0; j < 8; ++j) { const int k = k8 * 8 + j; v[j] = p.w_down[((size_t)l * DFF + k) * D + n]; }
        *(u32x4*)(W4 + ((size_t)l * D + n) * DFF + k8 * 8) = pack8(v);
    }
    bf16_t* PW = (bf16_t*)(ws + WS_PW);
    for (long i = gt; i < (long)DEPTH * 4 * 96 * 96; i += gs) {
        const int k = (int)(i % 96), n = (int)((i / 96) % 96), lg = (int)(i / (96 * 96)), l = lg >> 2, g = lg & 3;
        const float v = p.pool_w[((size_t)lg * 96 + k) * 96 + n] * p.pool_scale[l * 384 + g * 96 + n];
        PW[i] = (bf16_t)(cvt_pk_bf16(v, 0.f) & 0xffff);
    }
    bf16_t* DPm = (bf16_t*)(ws + WS_DP); bf16_t* DSm = (bf16_t*)(ws + WS_DS);
    for (long i = gt; i < (long)MPP * KP; i += gs) {
        const int kk = (int)(i % KP), k2 = (int)(i / KP), part = kk / KHP, n2 = kk % KHP;
        float v = 0.f;
        if (k2 < L2P && n2 < L2P) { const float a = (float)(2 * ((k2 * n2) % L2P)) * (1.0f / (float)L2P); v = part == 0 ? cospif(a) : sinpif(a); }
        DPm[i] = (bf16_t)(cvt_pk_bf16(v, 0.f) & 0xffff);
    }
    for (long i = gt; i < (long)MPS * KS; i += gs) {
        const int kk = (int)(i % KS), k2 = (int)(i / KS), part = kk / KHS, n2 = kk % KHS;
        float v = 0.f;
        if (k2 < L2S && n2 < L2S) { const float a = (float)(2 * ((k2 * n2) % L2S)) * (1.0f / (float)L2S); v = part == 0 ? cospif(a) : sinpif(a); }
        DSm[i] = (bf16_t)(cvt_pk_bf16(v, 0.f) & 0xffff);
    }
    f32x2* TWPt = (f32x2*)(ws + WS_TWP); f32x2* TWSt = (f32x2*)(ws + WS_TWS);
    for (long i = gt; i < 16 * KHP; i += gs) {
        const int n2 = (int)(i % KHP), k1 = (int)(i / KHP);
        const float a = (float)(2 * ((k1 * n2) % LP)) * (1.0f / (float)LP), sc = 1.0f / sqrtf(64.0f * (float)LP);
        TWPt[i] = (f32x2){cospif(a) * sc, -sinpif(a) * sc};
    }
    for (long i = gt; i < 16 * KHS; i += gs) {
        const int n2 = (int)(i % KHS), k1 = (int)(i / KHS);
        const float a = (float)(2 * ((k1 * n2) % LS)) * (1.0f / (float)LS), sc = 1.0f / sqrtf(64.0f * (float)LS);
        TWSt[i] = (f32x2){cospif(a) * sc, -sinpif(a) * sc};
    }
    bf16_t* hb = (bf16_t*)(ws + WS_HB); float* hm = (float*)(ws + WS_HM); float* ss1 = (float*)(ws + WS_SS1);
    const int lane = tid & 63, gw = (int)(gt >> 6), nw = (int)(gs >> 6);
    for (int r = gw; r < T; r += nw) {
        const float* src = r < 16384 ? p.x_prompt + (size_t)r * D : (r < TX ? p.x_sample + (size_t)(r - 16384) * D : p.meta + (size_t)((r - TX) & 15) * D);
        float* dst = r < TX ? p.out + (size_t)r * D : hm + (size_t)(r - TX) * D;
        float s = 0.f;
#pragma unroll
        for (int j = 0; j < 4; ++j) {
            const int c = j * 256 + lane * 4;
            const f32x4 v = *(const f32x4*)(src + c);
            *(f32x4*)(dst + c) = v;
            u32x2 w; w.x = cvt_pk_bf16(v[0], v[1]); w.y = cvt_pk_bf16(v[2], v[3]);
            *(u32x2*)(hb + (size_t)r * D + c) = w;
            s += (v[0] * v[0] + v[1] * v[1]) + (v[2] * v[2] + v[3] * v[3]);
        }
#pragma unroll
        for (int o = 32; o >= 1; o >>= 1) s += __shfl_xor(s, o);
        if (lane == 0) *(f32x4*)(ss1 + (size_t)r * 4) = (f32x4){s, 0.f, 0.f, 0.f};
    }
}

DEV void phase_gemm1(const Params& p, int l, LAS unsigned char* lds) {
    unsigned char* ws = p.ws;
    Epi1 e{(bf16_t*)(ws + WS_Z), (const float*)(ws + WS_SS1)};
    const bf16_t* A = (const bf16_t*)(ws + WS_HB); const bf16_t* B = (const bf16_t*)(ws + WS_W1) + (size_t)l * NZ * D;
    for (int t = blockIdx.x; t < 193 * 8; t += gridDim.x) { int pm, pn; tile_map(t, 193, 8, pm, pn); gemm_tile<0>(lds, A, D, B, D, D, pm * 256, pn * 256, e); }
}
DEV void phase_gemm2(const Params& p, int l, LAS unsigned char* lds) {
    unsigned char* ws = p.ws;
    EpiRes e{p.out, (float*)(ws + WS_HM), (bf16_t*)(ws + WS_HB), (float*)(ws + WS_SS2)};
    const bf16_t* A = (const bf16_t*)(ws + WS_MIX); const bf16_t* B = (const bf16_t*)(ws + WS_W2) + (size_t)l * D * D;
    for (int t = blockIdx.x; t < 193 * 4; t += gridDim.x) { int pm, pn; tile_map(t, 193, 4, pm, pn); gemm_tile<0>(lds, A, D, B, D, D, pm * 256, pn * 256, e); }
}
DEV void phase_gemm3(const Params& p, int l, LAS unsigned char* lds) {
    unsigned char* ws = p.ws;
    Epi3 e{(bf16_t*)(ws + WS_ACT), (const float*)(ws + WS_SS2)};
    const bf16_t* A = (const bf16_t*)(ws + WS_HB); const bf16_t* B = (const bf16_t*)(ws + WS_W3) + (size_t)l * NGU * D;
    for (int t = blockIdx.x; t < 193 * 22; t += gridDim.x) { int pm, pn; tile_map(t, 193, 22, pm, pn); gemm_tile<0>(lds, A, D, B, D, D, pm * 256, pn * 256, e); }
}
DEV void phase_gemm4(const Params& p, int l, LAS unsigned char* lds) {
    unsigned char* ws = p.ws;
    EpiRes e{p.out, (float*)(ws + WS_HM), (bf16_t*)(ws + WS_HB), (float*)(ws + WS_SS1)};
    const bf16_t* A = (const bf16_t*)(ws + WS_ACT); const bf16_t* B = (const bf16_t*)(ws + WS_W4) + (size_t)l * D * DFF;
    for (int t = blockIdx.x; t < 193 * 4; t += gridDim.x) { int pm, pn; tile_map(t, 193, 4, pm, pn); gemm_tile<0>(lds, A, DFF, B, DFF, DFF, pm * 256, pn * 256, e); }
}
DEV void dft_tile(const Params& p, int it, LAS unsigned char* lds) {
    unsigned char* ws = p.ws;
    bf16_t* mix = (bf16_t*)(ws + WS_MIX);
    if (it < 80) {
        const int pm = it % 5, pn = it / 5;
        EpiF e{mix, 0, pn, L2P};
        gemm_tile<1>(lds, (const bf16_t*)(ws + WS_DP), KP, (const bf16_t*)(ws + WS_WBP), NCP, KP, pm * 256, pn * 256, e);
    } else {
        const int j = it - 80, pm = j & 1, pn = j >> 1;
        EpiF e{mix, 1 + (pn >> 4), pn & 15, L2S};
        gemm_tile<1>(lds, (const bf16_t*)(ws + WS_DS), KS, (const bf16_t*)(ws + WS_WBS), NCS, KS, pm * 256, pn * 256, e);
    }
}
DEV void phase_dft(const Params& p, LAS unsigned char* lds) {
    const int b = blockIdx.x, G = gridDim.x;
    if (G == 256) {
        dft_tile(p, b < 80 ? b : b, lds);
        if (b >= 80 && b < 160) dft_tile(p, 256 + (b - 80), lds);
    } else {
        for (int it = b; it < 336; it += G) dft_tile(p, it, lds);
    }
}

DEV void xa_tile(const Params& p, int l, int s, int p0, int np, int L, LAS unsigned char* lds) {
    unsigned char* ws = p.ws;
    const bf16_t* z = (const bf16_t*)(ws + WS_Z); bf16_t* mix = (bf16_t*)(ws + WS_MIX);
    const float* cw = p.conv_w + (size_t)l * 3 * 384;
    const bf16_t* pw = (const bf16_t*)(ws + WS_PW) + (size_t)l * 4 * 96 * 96;
    int tid = threadIdx.x; asm volatile("" : "+v"(tid));
    const int wid = tid >> 6, lane = tid & 63, fr = lane & 15, fq = lane >> 4;
    LAS bf16_t* xs = (LAS bf16_t*)lds;
    LAS bf16_t* pre = (LAS bf16_t*)(lds + 79 * 784);
    LAS float* psum = (LAS float*)(lds + 79 * 784 + 64 * 784);
    const int nrows = np + 15;
    for (int c = tid; c < nrows * 48; c += NT) {
        const int i = c / 48, cg8 = c % 48, pp = p0 - 8 + i;
        u32x4 v = (u32x4){0u, 0u, 0u, 0u};
        if (pp >= 0 && pp < L) v = *(const u32x4*)(z + (size_t)rowof(s, pp) * NZ + 1152 + cg8 * 8);
        *(LAS u32x4*)(xs + i * 392 + cg8 * 8) = v;
    }
    for (int t = wid; t < np; t += 8) {
        const int pp = p0 + t, row = rowof(s, pp);
        float a[8]; float sq = 0.f;
        if (lane < 48) {
            const int c = lane * 8;
            const bf16_t* zr = z + (size_t)row * NZ + c;
            const u32x4 xa0 = *(const u32x4*)zr, gb0 = *(const u32x4*)(zr + 384), gc0 = *(const u32x4*)(zr + 768);
            u32x4 xam = (u32x4){0u, 0u, 0u, 0u}, gcm = xam, xap = xam, gcp = xam;
            if (pp > 0) { const bf16_t* q = z + (size_t)rowof(s, pp - 1) * NZ + c; xam = *(const u32x4*)q; gcm = *(const u32x4*)(q + 768); }
            if (pp < L - 1) { const bf16_t* q = z + (size_t)rowof(s, pp + 1) * NZ + c; xap = *(const u32x4*)q; gcp = *(const u32x4*)(q + 768); }
            const f32x4 w0a = *(const f32x4*)(cw + c), w0b = *(const f32x4*)(cw + c + 4);
            const f32x4 w1a = *(const f32x4*)(cw + 384 + c), w1b = *(const f32x4*)(cw + 384 + c + 4);
            const f32x4 w2a = *(const f32x4*)(cw + 768 + c), w2b = *(const f32x4*)(cw + 768 + c + 4);
#pragma unroll
            for (int j = 0; j < 4; ++j) {
                const float ym0 = bflo(xam[j]) * bflo(gcm[j]), ym1 = bfhi(xam[j]) * bfhi(gcm[j]);
                const float y00 = bflo(xa0[j]) * bflo(gc0[j]), y01 = bfhi(xa0[j]) * bfhi(gc0[j]);
                const float yp0 = bflo(xap[j]) * bflo(gcp[j]), yp1 = bfhi(xap[j]) * bfhi(gcp[j]);
                const int e0 = 2 * j, e1 = 2 * j + 1;
                const float k00 = e0 < 4 ? w0a[e0 & 3] : w0b[e0 & 3], k01 = e1 < 4 ? w0a[e1 & 3] : w0b[e1 & 3];
                const float k10 = e0 < 4 ? w1a[e0 & 3] : w1b[e0 & 3], k11 = e1 < 4 ? w1a[e1 & 3] : w1b[e1 & 3];
                const float k20 = e0 < 4 ? w2a[e0 & 3] : w2b[e0 & 3], k21 = e1 < 4 ? w2a[e1 & 3] : w2b[e1 & 3];
                a[e0] = bflo(gb0[j]) * (k00 * ym0 + k10 * y00 + k20 * yp0);
                a[e1] = bfhi(gb0[j]) * (k01 * ym1 + k11 * y01 + k21 * yp1);
                sq += a[e0] * a[e0] + a[e1] * a[e1];
            }
        } else {
#pragma unroll
            for (int j = 0; j < 8; ++j) a[j] = 0.f;
        }
#pragma unroll
        for (int o = 32; o >= 1; o >>= 1) sq += __shfl_xor(sq, o);
        const float rs = rsqrtf(sq * (1.0f / 384.0f) + EPS);
        if (lane < 48) {
#pragma unroll
            for (int j = 0; j < 8; ++j) a[j] *= rs;
            *(u32x4*)(mix + (size_t)row * D + lane * 8) = pack8(a);
        }
    }
    __syncthreads();
    for (int c = tid; c < np * 48; c += NT) {
        const int t = c / 48, cg8 = c % 48, gi = cg8 / 12, left = 1 << gi, right = left - 1;
        const int pp = p0 + t, lo = max(pp - left, 0), hi = min(pp + right, L - 1);
        float sm[8];
#pragma unroll
        for (int j = 0; j < 8; ++j) sm[j] = 0.f;
        for (int q = lo; q <= hi; ++q) {
            const u32x4 v = *(const LAS u32x4*)(xs + (q - p0 + 8) * 392 + cg8 * 8);
#pragma unroll
            for (int j = 0; j < 4; ++j) { sm[2 * j] += bflo(v[j]); sm[2 * j + 1] += bfhi(v[j]); }
        }
        const float inv = 1.0f / (float)(hi - lo + 1);
        const u32x4 sv = *(const LAS u32x4*)(xs + (t + 8) * 392 + cg8 * 8);
#pragma unroll
        for (int j = 0; j < 4; ++j) { sm[2 * j] = sm[2 * j] * inv - bflo(sv[j]); sm[2 * j + 1] = sm[2 * j + 1] * inv - bfhi(sv[j]); }
        *(LAS u32x4*)(pre + t * 392 + cg8 * 8) = pack8(sm);
    }
    __syncthreads();
    const int mb = wid & 3, gp = wid >> 2;
    const bool act = mb * 16 < np;
    f32x4 pacc[2][6];
#pragma unroll
    for (int it = 0; it < 2; ++it)
#pragma unroll
        for (int nb = 0; nb < 6; ++nb) pacc[it][nb] = (f32x4){0.f, 0.f, 0.f, 0.f};
    if (act) {
#pragma unroll
        for (int it = 0; it < 2; ++it) {
            const int g = gp * 2 + it;
#pragma unroll
            for (int ks = 0; ks < 3; ++ks) {
                const bf16x8 af = *(const LAS bf16x8*)(pre + (mb * 16 + fr) * 392 + g * 96 + ks * 32 + fq * 8);
#pragma unroll
                for (int nb = 0; nb < 6; ++nb) {
                    const bf16x8 bfm = *(const bf16x8*)(pw + ((size_t)g * 96 + nb * 16 + fr) * 96 + ks * 32 + fq * 8);
                    pacc[it][nb] = __builtin_amdgcn_mfma_f32_16x16x32_bf16(bfm, af, pacc[it][nb], 0, 0, 0);
                }
            }
            float q = 0.f;
#pragma unroll
            for (int nb = 0; nb < 6; ++nb) { const f32x4 v = pacc[it][nb]; q += (v[0] * v[0] + v[1] * v[1]) + (v[2] * v[2] + v[3] * v[3]); }
            q += __shfl_xor(q, 16); q += __shfl_xor(q, 32);
            if (fq == 0) psum[(mb * 16 + fr) * 4 + g] = q;
        }
    }
    __syncthreads();
    if (act) {
        const f32x4 e = *(const LAS f32x4*)(psum + (mb * 16 + fr) * 4);
        const float rs = rsqrtf(((e[0] + e[1]) + (e[2] + e[3])) * (1.0f / 384.0f) + EPS);
        const int row = rowof(s, p0 + mb * 16 + fr);
#pragma unroll
        for (int it = 0; it < 2; ++it)
#pragma unroll
            for (int nb = 0; nb < 6; ++nb) {
                const f32x4 v = pacc[it][nb] * rs;
                u32x2 w; w.x = cvt_pk_bf16(v[0], v[1]); w.y = cvt_pk_bf16(v[2], v[3]);
                *(u32x2*)(mix + (size_t)row * D + 384 + (gp * 2 + it) * 96 + nb * 16 + fq * 4) = w;
            }
    }
    __syncthreads();
}

DEV void phase_xa(const Params& p, int l, LAS unsigned char* lds) {
    int g0 = (int)((long)blockIdx.x * NGROUPS / gridDim.x);
    const int g1 = (int)((long)(blockIdx.x + 1) * NGROUPS / gridDim.x);
    while (g0 < g1) {
        int s, gs, gl;
        if (g0 < 1025) { s = 0; gs = 0; gl = 1025; } else { const int q = (g0 - 1025) / 257; s = 1 + q; gs = 1025 + 257 * q; gl = 257; }
        const int ng = min(4, min(g1, gs + gl) - g0);
        xa_tile(p, l, s, (g0 - gs) * 16, ng * 16, gl * 16, lds);
        g0 += ng;
    }
}

DEV void dft4(float& ar, float& ai, float& br, float& bi, float& cr, float& ci, float& dr, float& di) {
    const float s0r = ar + cr, s0i = ai + ci, d0r = ar - cr, d0i = ai - ci;
    const float s1r = br + dr, s1i = bi + di, d1r = br - dr, d1i = bi - di;
    ar = s0r + s1r; ai = s0i + s1i; cr = s0r - s1r; ci = s0i - s1i;
    br = d0r + d1i; bi = d0i - d1r; dr = d0r - d1i; di = d0i + d1r;
}
DEV void cmulc(float& r, float& i, float c, float s) { const float tr = r * c - i * s, ti = r * s + i * c; r = tr; i = ti; }

DEV void phase_xb(const Params& p, LAS unsigned char*) {
    unsigned char* ws = p.ws;
    const bf16_t* z = (const bf16_t*)(ws + WS_Z);
    int tid = threadIdx.x; asm volatile("" : "+v"(tid));
    const int m = tid & 255, half = tid >> 8;
    for (int it = blockIdx.x; it < 136 + 8 * 40; it += gridDim.x) {
        int s, gq, L2, KH, N, colbase; const f32x2* tw; bf16_t* wb;
        if (it < 136) { s = 0; gq = it; L2 = L2P; KH = KHP; N = NCP; colbase = 0; tw = (const f32x2*)(ws + WS_TWP); wb = (bf16_t*)(ws + WS_WBP); }
        else { const int j = it - 136; s = 1 + j / 40; gq = j % 40; L2 = L2S; KH = KHS; N = NCS; colbase = (s - 1) * 4096; tw = (const f32x2*)(ws + WS_TWS); wb = (bf16_t*)(ws + WS_WBS); }
        unsigned outr[16][2], outi[16][2];
#pragma unroll
        for (int i2 = 0; i2 < 2; ++i2) {
            float pr[2][16], pi[2][16];
#pragma unroll
            for (int i1 = 0; i1 < 2; ++i1) {
                const int n2 = 8 * gq + 4 * half + 2 * i2 + i1;
                float xr[16], xi[16];
                if (n2 < L2) {
#pragma unroll
                    for (int n1 = 0; n1 < 16; ++n1) {
                        const bf16_t* q = z + (size_t)rowof(s, L2 * n1 + n2) * NZ + 1536 + m;
                        xr[n1] = bf2f(q[0]); xi[n1] = bf2f(q[256]);
                    }
#pragma unroll
                    for (int b = 0; b < 4; ++b) dft4(xr[b], xi[b], xr[4 + b], xi[4 + b], xr[8 + b], xi[8 + b], xr[12 + b], xi[12 + b]);
                    const float C1 = 0.92387953251128674f, S1 = 0.38268343236508977f, R2 = 0.70710678118654752f;
                    cmulc(xr[5], xi[5], C1, -S1);
                    cmulc(xr[6], xi[6], R2, -R2);
                    cmulc(xr[7], xi[7], S1, -C1);
                    cmulc(xr[9], xi[9], R2, -R2);
                    cmulc(xr[10], xi[10], 0.f, -1.f);
                    cmulc(xr[11], xi[11], -R2, -R2);
                    cmulc(xr[13], xi[13], S1, -C1);
                    cmulc(xr[14], xi[14], -R2, -R2);
                    cmulc(xr[15], xi[15], -C1, S1);
#pragma unroll
                    for (int c = 0; c < 4; ++c) dft4(xr[4 * c], xi[4 * c], xr[4 * c + 1], xi[4 * c + 1], xr[4 * c + 2], xi[4 * c + 2], xr[4 * c + 3], xi[4 * c + 3]);
#pragma unroll
                    for (int c = 0; c < 4; ++c)
#pragma unroll
                        for (int d = 0; d < 4; ++d) {
                            const int k1 = c + 4 * d;
                            const f32x2 t2 = tw[k1 * KH + n2];
                            const float r = xr[4 * c + d], i = xi[4 * c + d];
                            pr[i1][k1] = r * t2[0] - i * t2[1]; pi[i1][k1] = r * t2[1] + i * t2[0];
                        }
                } else {
#pragma unroll
                    for (int k1 = 0; k1 < 16; ++k1) { pr[i1][k1] = 0.f; pi[i1][k1] = 0.f; }
                }
            }
#pragma unroll
            for (int k1 = 0; k1 < 16; ++k1) { outr[k1][i2] = cvt_pk_bf16(pr[0][k1], pr[1][k1]); outi[k1][i2] = cvt_pk_bf16(pi[0][k1], pi[1][k1]); }
        }
#pragma unroll
        for (int k1 = 0; k1 < 16; ++k1) {
            const size_t col = (size_t)colbase + k1 * 256 + m;
            *(u32x2*)(wb + ((size_t)gq * N + col) * 8 + half * 4) = (u32x2){outr[k1][0], outr[k1][1]};
            *(u32x2*)(wb + ((size_t)(KH / 8 + gq) * N + col) * 8 + half * 4) = (u32x2){outi[k1][0], outi[k1][1]};
        }
    }
}

DEV void phase_final(const Params& p) {
    const float* ss = (const float*)(p.ws + WS_SS1);
    int tid = threadIdx.x; asm volatile("" : "+v"(tid));
    const int lane = tid & 63;
    const int gw = (int)(((long)blockIdx.x * NT + tid) >> 6), nw = (int)(((long)gridDim.x * NT) >> 6);
    for (int r = gw; r < TX; r += nw) {
        const float rs = row_rs(ss, r);
        float* h = p.out + (size_t)r * D;
#pragma unroll
        for (int j = 0; j < 4; ++j) {
            const int c = j * 256 + lane * 4;
            const f32x4 v = *(const f32x4*)(h + c), g = *(const f32x4*)(p.final_g + c);
            *(f32x4*)(h + c) = v * rs * g;
        }
    }
}

#if MEGA
__global__ void __launch_bounds__(NT, 2) fwd_mega(Params p) {
    extern __shared__ __attribute__((aligned(16))) unsigned char lds_raw[];
    LAS unsigned char* lds = (LAS unsigned char*)lds_raw;
    cg::grid_group grid = cg::this_grid();
    phase_prologue(p, lds);
    grid.sync();
    for (int l = 0; l < DEPTH; ++l) {
        phase_gemm1(p, l, lds); grid.sync();
        phase_xa(p, l, lds); phase_xb(p, lds); grid.sync();
        phase_dft(p, lds); grid.sync();
        phase_gemm2(p, l, lds); grid.sync();
        phase_gemm3(p, l, lds); grid.sync();
        phase_gemm4(p, l, lds); grid.sync();
    }
    phase_final(p);
}
#else
template <int PH> __global__ void __launch_bounds__(NT, 2) phase_kernel(Params p, int l) {
    extern __shared__ __attribute__((aligned(16))) unsigned char lds_raw[];
    LAS unsigned char* lds = (LAS unsigned char*)lds_raw;
    if (PH == 0) phase_prologue(p, lds);
    if (PH == 1) phase_gemm1(p, l, lds);
    if (PH == 2) { phase_xa(p, l, lds); phase_xb(p, lds); }
    if (PH == 3) phase_dft(p, lds);
    if (PH == 4) phase_gemm2(p, l, lds);
    if (PH == 5) phase_gemm3(p, l, lds);
    if (PH == 6) phase_gemm4(p, l, lds);
    if (PH == 7) phase_final(p);
}
template <int PH> static void launch_phase(const Params& p, int l, hipStream_t stream) {
    static bool attr = false;
    if (!attr) { (void)hipFuncSetAttribute((const void*)phase_kernel<PH>, hipFuncAttributeMaxDynamicSharedMemorySize, LDS_BYTES); attr = true; }
    hipLaunchKernelGGL(phase_kernel<PH>, dim3(256), dim3(NT), LDS_BYTES, stream, p, l);
}
#endif

extern "C" void kernel_launch(void* const* d_in, const int* in_sizes, int n_in, void* d_out, int out_size, void* d_ws, size_t ws_size, hipStream_t stream) {
    if (n_in != 14 || ws_size < WS_END || out_size != TX * D) { fprintf(stderr, "kernel_launch: unexpected shapes (n_in %d, ws %zu need %zu, out %d)\n", n_in, ws_size, (size_t)WS_END, out_size); return; }
    Params p{};
    p.x_prompt = (const float*)d_in[0]; p.x_sample = (const float*)d_in[1]; p.meta = (const float*)d_in[2]; p.norm1_g = (const float*)d_in[3];
    p.w_in = (const float*)d_in[4]; p.conv_w = (const float*)d_in[5]; p.pool_w = (const float*)d_in[6]; p.pool_scale = (const float*)d_in[7];
    p.mix_g = (const float*)d_in[8]; p.w_out = (const float*)d_in[9]; p.norm2_g = (const float*)d_in[10]; p.w_gate_up = (const float*)d_in[11];
    p.w_down = (const float*)d_in[12]; p.final_g = (const float*)d_in[13];
    p.out = (float*)d_out; p.ws = (unsigned char*)d_ws;
#if MEGA
    static int grid = 0;
    if (grid == 0) {
        int dev = 0, cus = 0, per_cu = 0;
        (void)hipGetDevice(&dev);
        (void)hipDeviceGetAttribute(&cus, hipDeviceAttributeMultiprocessorCount, dev);
        (void)hipFuncSetAttribute((const void*)fwd_mega, hipFuncAttributeMaxDynamicSharedMemorySize, LDS_BYTES);
        (void)hipOccupancyMaxActiveBlocksPerMultiprocessor(&per_cu, (const void*)fwd_mega, NT, LDS_BYTES);
        if (per_cu < 1) per_cu = 1;
        grid = cus * per_cu;
        if (grid > 256) grid = 256;
    }
    void* args[] = {&p};
    hipError_t e = hipLaunchCooperativeKernel((const void*)fwd_mega, dim3(grid), dim3(NT), args, LDS_BYTES, stream);
    if (e != hipSuccess) fprintf(stderr, "cooperative launch failed: %s (grid %d)\n", hipGetErrorString(e), grid);
#else
    launch_phase<0>(p, 0, stream);
    for (int l = 0; l < DEPTH; ++l) {
        launch_phase<1>(p, l, stream); launch_phase<2>(p, l, stream); launch_phase<3>(p, l, stream);
        launch_phase<4>(p, l, stream); launch_phase<5>(p, l, stream); launch_phase<6>(p, l, stream);
    }
    launch_phase<7>(p, 0, stream);
#endif
}
```

```cpp
#include <hip/hip_runtime.h>
#include <hip/hip_cooperative_groups.h>
#include <cstdio>
#include <cstdint>
namespace cg = cooperative_groups;

#ifndef MEGA
#define MEGA 1
#endif

#define LAS __attribute__((address_space(3)))
#define DEV __device__ __forceinline__
typedef unsigned short bf16_t;
typedef short bf16x8 __attribute__((ext_vector_type(8)));
typedef float f32x4 __attribute__((ext_vector_type(4)));
typedef float f32x2 __attribute__((ext_vector_type(2)));
typedef unsigned u32x4 __attribute__((ext_vector_type(4)));
typedef unsigned u32x2 __attribute__((ext_vector_type(2)));

constexpr int D = 1024, NZ = 2048, DFF = 2816, NGU = 5632, DEPTH = 4, NIN0 = 1792;
constexpr int TX = 49152, TMETA = 144, T = TX + TMETA, TP = TX + 256;
constexpr int LP = 16400, LS = 4112, L2P = 1025, L2S = 257;
constexpr int KHP = 1088, KHS = 320, KP = 2 * KHP, KS = 2 * KHS, MPP = 1280, MPS = 512;
constexpr int NCP = 4096, NCS = 32768;
constexpr int NGROUPS = 3081;
constexpr float EPS = 1e-6f;
constexpr int LDS_BYTES = 131072 + 8192 + 16;
constexpr int NT = 512;
constexpr int XCD_BAR_WORDS_C = 3456 + 256;
constexpr int VCNT_WORD0 = 3456;
constexpr int MCNT_WORD0 = 3456 + 32;
constexpr int NVTILES = 192 + 9;
constexpr int LDS_EX = 131072;
constexpr int LDS_CTL = 131072 + 8192;

constexpr size_t al(size_t x) { return (x + 255) & ~size_t(255); }
constexpr size_t WS_W1 = 0;
constexpr size_t WS_W2 = WS_W1 + al((size_t)DEPTH * NZ * D * 2);
constexpr size_t WS_W3 = WS_W2 + al((size_t)DEPTH * D * D * 2);
constexpr size_t WS_W4 = WS_W3 + al((size_t)DEPTH * NGU * D * 2);
constexpr size_t WS_PW = WS_W4 + al((size_t)DEPTH * D * DFF * 2);
constexpr size_t WS_DP = WS_PW + al((size_t)DEPTH * 4 * 96 * 96 * 2);
constexpr size_t WS_DS = WS_DP + al((size_t)MPP * KP * 2);
constexpr size_t WS_TWP = WS_DS + al((size_t)MPS * KS * 2);
constexpr size_t WS_TWS = WS_TWP + al((size_t)16 * KHP * 8);
constexpr size_t WS_SS1 = WS_TWS + al((size_t)16 * KHS * 8);
constexpr size_t WS_SS2 = WS_SS1 + al((size_t)TP * 4 * 4);
constexpr size_t WS_HM = WS_SS2 + al((size_t)TP * 4 * 4);
constexpr size_t WS_HB = WS_HM + al((size_t)256 * D * 4);
constexpr size_t WS_Z = WS_HB + al((size_t)TP * D * 2);
constexpr size_t WS_MIX = WS_Z + al((size_t)TP * NZ * 2);
constexpr size_t WS_BAR = WS_MIX + al((size_t)TP * D * 2);
constexpr size_t WS_END = WS_BAR + al((size_t)XCD_BAR_WORDS_C * 4);
constexpr size_t OUT_WBP = 0;
constexpr size_t OUT_WBS = (size_t)KP * NCP * 2;
constexpr size_t WS_ACT = WS_Z;
static_assert((size_t)KP * NCP * 2 + (size_t)KS * NCS * 2 <= (size_t)TX * D * 4, "WB in d_out");
static_assert((size_t)TP * DFF * 2 <= (WS_BAR - WS_Z), "ACT overlay");

struct Params {
    const float *x_prompt, *x_sample, *meta, *norm1_g, *w_in, *conv_w, *pool_w, *pool_scale, *mix_g, *w_out, *norm2_g, *w_gate_up, *w_down, *final_g;
    float* out; unsigned char* ws;
};

DEV unsigned cvt_pk_bf16(float lo, float hi) { unsigned r; asm("v_cvt_pk_bf16_f32 %0, %1, %2" : "=v"(r) : "v"(lo), "v"(hi)); return r; }
DEV float bflo(unsigned w) { return __uint_as_float(w << 16); }
DEV float bfhi(unsigned w) { return __uint_as_float(w & 0xffff0000u); }
DEV float bf2f(bf16_t v) { return __uint_as_float((unsigned)v << 16); }

DEV u32x4 pack8(const float (&v)[8]) { u32x4 w; w.x = cvt_pk_bf16(v[0], v[1]); w.y = cvt_pk_bf16(v[2], v[3]); w.z = cvt_pk_bf16(v[4], v[5]); w.w = cvt_pk_bf16(v[6], v[7]); return w; }

typedef __amdgpu_buffer_rsrc_t rsrc_t;
DEV rsrc_t make_rsrc(const void* base, unsigned bytes) { return __builtin_amdgcn_make_buffer_rsrc((void*)base, 0, (int)bytes, 0x00020000); }
DEV void st16_wt(rsrc_t r, unsigned byte_off, u32x4 v) { __builtin_amdgcn_raw_buffer_store_b128(v, r, byte_off, 0, 16); }

DEV int seq_xbase(int s) { return s == 0 ? 0 : 16384 + 4096 * (s - 1); }
DEV int rowof(int s, int p) { return p < 16 ? TX + 16 * s + p : seq_xbase(s) + p - 16; }

DEV int swz_off(int fr, int fq) { int ob = fr * 64 + fq * 16; return ob ^ (((ob >> 9) & 1) << 5); }
DEV void stage_rc(int b, int& R, int& C) { int st = b >> 10, sb = b & 1023, swz = sb ^ (((sb >> 9) & 1) << 5); R = (st >> 1) * 16 + (swz >> 6); C = (st & 1) * 32 + ((swz & 63) >> 1); }

#define GLDS(g, l) __builtin_amdgcn_global_load_lds((const unsigned*)(g), (LAS unsigned*)(l), 16, 0, 0)
#define WAIT_V(n) asm volatile("s_waitcnt vmcnt(" #n ")" ::: "memory")
#define WAIT_L(n) asm volatile("s_waitcnt lgkmcnt(" #n ")" ::: "memory")
#define BAR __builtin_amdgcn_s_barrier()
#define SCHED __builtin_amdgcn_sched_barrier(0)

template <int BMODE, class Epi, class TileFn>
DEV void gemm_loop(LAS unsigned char* lds, const bf16_t* __restrict__ A, int lda, const bf16_t* __restrict__ B, int ldb, int K, const Epi& epi, int t0, int tstep, int tend, const TileFn& tf) {
    if (t0 >= tend) return;
    int tid = threadIdx.x; asm volatile("" : "+v"(tid));
    const int wid = tid >> 6, lane = tid & 63, wr = wid >> 2, wc = wid & 3, fr = lane & 15, fq = lane >> 4;
    int r0, c0; stage_rc(tid * 16, r0, c0);
    const unsigned voa0 = (unsigned)(r0 * lda + c0) * 2u, voa1 = voa0 + (unsigned)(64 * lda) * 2u;
    const size_t ahalf = (size_t)128 * lda * 2;
    unsigned vob0, vob1; size_t bks, bhalf;
    const int r0b = Epi::PERM ? ((r0 & ~31) + 8 * ((r0 & 15) >> 2) + 4 * ((r0 >> 4) & 1) + (r0 & 3)) : r0;
    if (BMODE == 0) { vob0 = (unsigned)(r0b * ldb + c0) * 2u; vob1 = vob0 + (unsigned)(64 * ldb) * 2u; bks = 128; bhalf = (size_t)128 * ldb * 2; }
    else { vob0 = (unsigned)((c0 >> 3) * ldb + r0b) * 16u; vob1 = vob0 + 64u * 16u; bks = (size_t)ldb * 128; bhalf = 128 * 16; }
    LAS unsigned char* lw = lds + tid * 16;
    const int sw = swz_off(fr, fq);
    LAS unsigned char* la = lds + wr * 8192 + sw;
    LAS unsigned char* lb = lds + 65536 + wc * 4096 + sw;
    int brow, bcol; tf(t0, brow, bcol);
    const char* cA = (const char*)(A + (size_t)brow * lda);
    const char* cB = BMODE == 0 ? (const char*)(B + (size_t)bcol * ldb) : (const char*)(B + (size_t)bcol * 8);

#define STG_A(b, h, ptr) do { const char* _g = (ptr) + (h) * ahalf; LAS unsigned char* _l = lw + ((b) * 2 + (h)) * 16384; GLDS(_g + voa0, _l); GLDS(_g + voa1, _l + 8192); } while (0)
#define STG_B(b, h, ptr) do { const char* _g = (ptr) + (h) * bhalf; LAS unsigned char* _l = lw + 65536 + ((b) * 2 + (h)) * 16384; GLDS(_g + vob0, _l); GLDS(_g + vob1, _l + 8192); } while (0)
#define LDA(dst, b, h) _Pragma("unroll") for (int m = 0; m < 4; ++m) _Pragma("unroll") for (int k = 0; k < 2; ++k) dst[m][k] = *(const LAS bf16x8*)(la + ((b) * 2 + (h)) * 16384 + m * 2048 + k * 1024)
#define LDB(dst, b, h) _Pragma("unroll") for (int n = 0; n < 2; ++n) _Pragma("unroll") for (int k = 0; k < 2; ++k) dst[n][k] = *(const LAS bf16x8*)(lb + ((b) * 2 + (h)) * 16384 + n * 2048 + k * 1024)
#define MMA(ai, bj, Af, Bf) do { __builtin_amdgcn_s_setprio(1); \
    _Pragma("unroll") for (int m = 0; m < 4; ++m) _Pragma("unroll") for (int n = 0; n < 2; ++n) _Pragma("unroll") for (int k = 0; k < 2; ++k) \
        acc[ai][bj][m][n] = __builtin_amdgcn_mfma_f32_16x16x32_bf16(Bf[n][k], Af[m][k], acc[ai][bj][m][n], 0, 0, 0); \
    __builtin_amdgcn_s_setprio(0); } while (0)

    const int nt = K / 64;
    f32x4 acc[2][2][4][2];
#pragma unroll
    for (int a = 0; a < 2; ++a)
#pragma unroll
        for (int b = 0; b < 2; ++b)
#pragma unroll
            for (int m = 0; m < 4; ++m)
#pragma unroll
                for (int n = 0; n < 2; ++n) acc[a][b][m][n] = (f32x4){0.f, 0.f, 0.f, 0.f};
    bf16x8 At[4][2], B0[2][2], B1[2][2];
    STG_B(0, 0, cB); STG_B(0, 1, cB); STG_A(0, 0, cA); STG_A(0, 1, cA);
    if (wr == 1) BAR;
    WAIT_V(2); BAR;
    STG_B(1, 0, cB + bks); STG_A(1, 0, cA + 128); STG_B(1, 1, cB + bks);
    WAIT_V(6); BAR;
    int par = 0;
    for (int tt = t0;; tt += tstep, par ^= 1) {
        const bool has_next = tt + tstep < tend;
        epi.prefetch(lds, brow, par, tid);
        int nrow = brow, ncol = bcol;
        if (has_next) tf(tt + tstep, nrow, ncol);
        const char* nA = (const char*)(A + (size_t)nrow * lda);
        const char* nB = BMODE == 0 ? (const char*)(B + (size_t)ncol * ldb) : (const char*)(B + (size_t)ncol * 8);
        for (int t = 0; t < nt; t += 2) {
            const bool last = (t == nt - 2);
            const char* a1 = cA + (size_t)(t + 1) * 128;
            const char* a2 = last ? nA : cA + (size_t)(t + 2) * 128;
            const char* b2 = last ? nB : cB + (size_t)(t + 2) * bks;
            const char* a3 = a2 + 128; const char* b3 = b2 + bks;
            LDB(B0, 0, 0); LDB(B1, 0, 1); SCHED; LDA(At, 0, 0); STG_A(1, 1, a1);
            WAIT_V(8); WAIT_L(0); BAR; MMA(0, 0, At, B0); MMA(0, 1, At, B1); BAR; SCHED;
            LDA(At, 0, 1); STG_B(0, 0, b2); STG_B(0, 1, b2); STG_A(0, 0, a2);
            WAIT_V(8); WAIT_L(0); BAR; MMA(1, 0, At, B0); MMA(1, 1, At, B1); BAR; SCHED;
            LDB(B0, 1, 0); LDB(B1, 1, 1); SCHED; LDA(At, 1, 0); STG_A(0, 1, a2);
            WAIT_V(8); WAIT_L(0); BAR; MMA(0, 0, At, B0); MMA(0, 1, At, B1); BAR; SCHED;
            LDA(At, 1, 1); STG_B(1, 0, b3); STG_B(1, 1, b3); STG_A(1, 0, a3);
            WAIT_V(8); WAIT_L(0); BAR; MMA(1, 0, At, B0); MMA(1, 1, At, B1); BAR; SCHED;
        }
        if (wr == 0) BAR;
        epi(acc, brow, bcol, lds, par);
        if (!has_next) break;
#pragma unroll
        for (int a = 0; a < 2; ++a)
#pragma unroll
            for (int b = 0; b < 2; ++b)
#pragma unroll
                for (int m = 0; m < 4; ++m)
#pragma unroll
                    for (int n = 0; n < 2; ++n) acc[a][b][m][n] = (f32x4){0.f, 0.f, 0.f, 0.f};
        brow = nrow; bcol = ncol; cA = nA; cB = nB;
        if (wr == 1) BAR;
    }
    WAIT_V(0);
    BAR;
#undef STG_A
#undef STG_B
#undef LDA
#undef LDB
#undef MMA
}

DEV void skinny_reduce(LAS unsigned char* lds, int wid, int lane, const f32x4 (&acc)[16], f32x4& a0, f32x4& a1) {
#pragma unroll
    for (int nb = 0; nb < 16; ++nb) *(LAS f32x4*)(lds + ((wid * 16 + nb) * 64 + lane) * 16) = acc[nb];
    __syncthreads();
    a0 = (f32x4){0.f, 0.f, 0.f, 0.f}; a1 = a0;
#pragma unroll
    for (int w = 0; w < 8; ++w) { a0 += *(const LAS f32x4*)(lds + ((w * 16 + 2 * wid) * 64 + lane) * 16); a1 += *(const LAS f32x4*)(lds + ((w * 16 + 2 * wid + 1) * 64 + lane) * 16); }
    __syncthreads();
}
template <class Epi>
DEV void skinny_item(LAS unsigned char* lds, const bf16_t* __restrict__ A, int lda, const bf16_t* __restrict__ B, int ldb, int K, int mb, int pn, const Epi& epi) {
    int tid = threadIdx.x; asm volatile("" : "+v"(tid));
    const int wid = tid >> 6, lane = tid & 63, fr = lane & 15, fq = lane >> 4;
    const bf16_t* ap = A + (size_t)(TX + mb * 16 + fr) * lda + fq * 8;
    const bf16_t* bp = B + (size_t)(pn * 256 + fr) * ldb + fq * 8;
    const size_t b16 = (size_t)16 * ldb;
    f32x4 acc[16];
#pragma unroll
    for (int nb = 0; nb < 16; ++nb) acc[nb] = (f32x4){0.f, 0.f, 0.f, 0.f};
    const int nsteps = K >> 5;
#pragma unroll 1
    for (int st = wid; st < nsteps; st += 8) {
        const int k0 = st * 32;
        const bf16x8 a = *(const bf16x8*)(ap + k0);
        bf16x8 b[16];
#pragma unroll
        for (int nb = 0; nb < 16; ++nb) b[nb] = *(const bf16x8*)(bp + nb * b16 + k0);
        SCHED;
#pragma unroll
        for (int nb = 0; nb < 16; ++nb) acc[nb] = __builtin_amdgcn_mfma_f32_16x16x32_bf16(b[nb], a, acc[nb], 0, 0, 0);
        SCHED;
    }
    f32x4 a0, a1;
    skinny_reduce(lds, wid, lane, acc, a0, a1);
    epi.skinny(a0, a1, mb, pn, lds);
}

template <class Epi>
DEV void skinny_dft(LAS unsigned char* lds, const bf16_t* __restrict__ A, int lda, const bf16_t* __restrict__ B, int N, int K, int arow0, int ncol0, const Epi& epi) {
    int tid = threadIdx.x; asm volatile("" : "+v"(tid));
    const int wid = tid >> 6, lane = tid & 63, fr = lane & 15, fq = lane >> 4;
    const bf16_t* ap = A + (size_t)(arow0 + fr) * lda + fq * 8;
    const bf16_t* bp = B + ((size_t)fq * N + ncol0 + fr) * 8;
    const size_t bstep = (size_t)4 * N * 8;
    f32x4 acc[16];
#pragma unroll
    for (int nb = 0; nb < 16; ++nb) acc[nb] = (f32x4){0.f, 0.f, 0.f, 0.f};
    const int nsteps = K >> 5;
#pragma unroll 1
    for (int st = wid; st < nsteps; st += 8) {
        const bf16x8 a = *(const bf16x8*)(ap + st * 32);
        const bf16_t* bq = bp + st * bstep;
        bf16x8 b[16];
#pragma unroll
        for (int nb = 0; nb < 16; ++nb) b[nb] = *(const bf16x8*)(bq + nb * 128);
        SCHED;
#pragma unroll
        for (int nb = 0; nb < 16; ++nb) acc[nb] = __builtin_amdgcn_mfma_f32_16x16x32_bf16(b[nb], a, acc[nb], 0, 0, 0);
        SCHED;
    }
    f32x4 a0, a1;
    skinny_reduce(lds, wid, lane, acc, a0, a1);
    epi.skinny(a0, a1, lds);
}

struct TileMap { int nM, nN; DEV void operator()(int t, int& brow, int& bcol) const; };
struct TileMapRev { int nM, nN; DEV void operator()(int t, int& brow, int& bcol) const; };
struct TileG1 { DEV void operator()(int t, int& brow, int& bcol) const; };
struct TileOne { int brow_, bcol_; DEV void operator()(int, int& brow, int& bcol) const { brow = brow_; bcol = bcol_; } };

DEV void tile_map(int L, int nM, int nN, int& pm, int& pn) {
    const int nwg = nM * nN; int wgid = L;
    { const int q = nwg / 8, r = nwg % 8, xcd = wgid % 8, off = wgid / 8; wgid = (xcd < r ? xcd * (q + 1) : r * (q + 1) + (xcd - r) * q) + off; }
    const int nig = 4 * nN, gid = wgid / nig, fm = gid * 4, gsz = (nM - fm) < 4 ? (nM - fm) : 4;
    pm = fm + ((wgid % nig) % gsz); pn = (wgid % nig) / gsz;
}

DEV void TileMap::operator()(int t, int& brow, int& bcol) const { int pm, pn; tile_map(t, nM, nN, pm, pn); brow = pm * 256; bcol = pn * 256; }
DEV void TileG1::operator()(int t, int& brow, int& bcol) const { int pm, pn; tile_map(t, 192, 7, pm, pn); brow = pm * 256; bcol = (pn == 0 ? 6 : pn - 1) * 256; }
DEV void TileMapRev::operator()(int t, int& brow, int& bcol) const { int pm, pn; tile_map(t, nM, nN, pm, pn); brow = (nM - 1 - pm) * 256; bcol = pn * 256; }

#define EPI_IDS int tid = threadIdx.x; asm volatile("" : "+v"(tid)); const int wid = tid >> 6, lane = tid & 63, wr = wid >> 2, wc = wid & 3, fr = lane & 15, fq = lane >> 4; (void)wc; (void)fq; (void)fr; (void)wr;

DEV float row_rs(const float* ss, int row) { const f32x4 s4 = *(const f32x4*)(ss + (size_t)row * 4); return rsqrtf(((s4[0] + s4[1]) + (s4[2] + s4[3])) * (1.0f / 1024.0f) + EPS); }

struct Epi1 {
    static constexpr bool PERM = true;
    bf16_t* z; const float* ss; unsigned* vcnt;
    DEV void prefetch(LAS unsigned char* lds, int brow, int par, int tid) const { if (tid < 256) GLDS(ss + (size_t)(brow + tid) * 4, lds + LDS_EX + par * 4096 + tid * 16); }
    DEV void publish(int tid) const {
        asm volatile("s_waitcnt vmcnt(0)" ::: "memory");
        __syncthreads();
        if (tid == 0) (void)__hip_atomic_fetch_add(vcnt, 1u, __ATOMIC_RELAXED, __HIP_MEMORY_SCOPE_AGENT);
    }
    DEV void publish_fenced(int tid) const {
        asm volatile("s_waitcnt vmcnt(0)" ::: "memory");
        __syncthreads();
        if (tid == 0) { __builtin_amdgcn_fence(__ATOMIC_RELEASE, "agent"); asm volatile("s_waitcnt vmcnt(0)" ::: "memory"); (void)__hip_atomic_fetch_add(vcnt, 1u, __ATOMIC_RELAXED, __HIP_MEMORY_SCOPE_AGENT); }
    }
    DEV void operator()(f32x4 (&acc)[2][2][4][2], int brow, int bcol, LAS unsigned char* lds, int par) const {
        EPI_IDS
        const rsrc_t zr = make_rsrc(z, (unsigned)((size_t)TP * NZ * 2));
        const bool vt = bcol == 6 * 256;
#pragma unroll
        for (int ai = 0; ai < 2; ++ai)
#pragma unroll
            for (int m = 0; m < 4; ++m) {
                const int lr = ai * 128 + wr * 64 + m * 16 + fr, row = brow + lr;
                const f32x4 s4 = *(const LAS f32x4*)(lds + LDS_EX + par * 4096 + lr * 16);
                const float rs = rsqrtf(((s4[0] + s4[1]) + (s4[2] + s4[3])) * (1.0f / 1024.0f) + EPS);
#pragma unroll
                for (int bj = 0; bj < 2; ++bj) {
                    const f32x4 v0 = acc[ai][bj][m][0] * rs, v1 = acc[ai][bj][m][1] * rs;
                    u32x4 w; w.x = cvt_pk_bf16(v0[0], v0[1]); w.y = cvt_pk_bf16(v0[2], v0[3]); w.z = cvt_pk_bf16(v1[0], v1[1]); w.w = cvt_pk_bf16(v1[2], v1[3]);
                    if (vt) st16_wt(zr, (unsigned)(row * NZ + bcol + bj * 128 + wc * 32 + fq * 8) * 2u, w);
                    else *(u32x4*)(z + (size_t)row * NZ + bcol + bj * 128 + wc * 32 + fq * 8) = w;
                }
            }
        if (vt) publish(tid);
    }
    DEV void skinny(f32x4 a0, f32x4 a1, int mb, int pn, LAS unsigned char*) const {
        EPI_IDS
        const int row = TX + mb * 16 + fr;
        const float rs = row_rs(ss, row);
        const f32x4 v0 = a0 * rs, v1 = a1 * rs;
        bf16_t* zp = z + (size_t)row * NZ + pn * 256 + wid * 32 + fq * 4;
        *(u32x2*)zp = (u32x2){cvt_pk_bf16(v0[0], v0[1]), cvt_pk_bf16(v0[2], v0[3])};
        *(u32x2*)(zp + 16) = (u32x2){cvt_pk_bf16(v1[0], v1[1]), cvt_pk_bf16(v1[2], v1[3])};
        if (pn == 6) publish_fenced(tid);
    }
};

struct EpiRes {
    static constexpr bool PERM = true;
    bf16_t* hb; float* ssout;
    DEV void prefetch(LAS unsigned char*, int, int, int) const {}
    DEV void operator()(f32x4 (&acc)[2][2][4][2], int brow, int bcol, LAS unsigned char* lds, int) const {
        EPI_IDS
        LAS float* ex = (LAS float*)(lds + LDS_EX);
        bf16_t* hp0 = hb + (size_t)(brow + wr * 64 + fr) * D + bcol + wc * 32 + fq * 8;
        u32x4 res[2][4][2];
#pragma unroll
        for (int ai = 0; ai < 2; ++ai)
#pragma unroll
            for (int m = 0; m < 4; ++m)
#pragma unroll
                for (int bj = 0; bj < 2; ++bj) res[ai][m][bj] = *(const u32x4*)(hp0 + (size_t)(ai * 128 + m * 16) * D + bj * 128);
        SCHED;
#pragma unroll
        for (int ai = 0; ai < 2; ++ai)
#pragma unroll
            for (int m = 0; m < 4; ++m) {
                const int lr = ai * 128 + wr * 64 + m * 16 + fr;
                float s = 0.f;
#pragma unroll
                for (int bj = 0; bj < 2; ++bj) {
                    const u32x4 r = res[ai][m][bj];
                    f32x4 v0 = acc[ai][bj][m][0], v1 = acc[ai][bj][m][1];
                    v0[0] += bflo(r.x); v0[1] += bfhi(r.x); v0[2] += bflo(r.y); v0[3] += bfhi(r.y);
                    v1[0] += bflo(r.z); v1[1] += bfhi(r.z); v1[2] += bflo(r.w); v1[3] += bfhi(r.w);
                    u32x4 w; w.x = cvt_pk_bf16(v0[0], v0[1]); w.y = cvt_pk_bf16(v0[2], v0[3]); w.z = cvt_pk_bf16(v1[0], v1[1]); w.w = cvt_pk_bf16(v1[2], v1[3]);
                    *(u32x4*)(hp0 + (size_t)(ai * 128 + m * 16) * D + bj * 128) = w;
                    s += ((v0[0] * v0[0] + v0[1] * v0[1]) + (v0[2] * v0[2] + v0[3] * v0[3])) + ((v1[0] * v1[0] + v1[1] * v1[1]) + (v1[2] * v1[2] + v1[3] * v1[3]));
                }
                s += __shfl_xor(s, 16); s += __shfl_xor(s, 32);
                if (fq == 0) ex[lr * 4 + wc] = s;
            }
        __syncthreads();
        if (tid < 256) { const f32x4 e = *(const LAS f32x4*)(ex + tid * 4); ssout[(size_t)(brow + tid) * 4 + (bcol >> 8)] = (e[0] + e[1]) + (e[2] + e[3]); }
    }
    DEV void skinny(f32x4 a0, f32x4 a1, int mb, int pn, LAS unsigned char* lds) const {
        EPI_IDS
        const int row = TX + mb * 16 + fr, col = pn * 256 + wid * 32 + fq * 4;
        bf16_t* bp = hb + (size_t)row * D + col;
        const u32x2 r0 = *(const u32x2*)bp, r1 = *(const u32x2*)(bp + 16);
        f32x4 v0 = a0, v1 = a1;
        v0[0] += bflo(r0.x); v0[1] += bfhi(r0.x); v0[2] += bflo(r0.y); v0[3] += bfhi(r0.y);
        v1[0] += bflo(r1.x); v1[1] += bfhi(r1.x); v1[2] += bflo(r1.y); v1[3] += bfhi(r1.y);
        *(u32x2*)bp = (u32x2){cvt_pk_bf16(v0[0], v0[1]), cvt_pk_bf16(v0[2], v0[3])};
        *(u32x2*)(bp + 16) = (u32x2){cvt_pk_bf16(v1[0], v1[1]), cvt_pk_bf16(v1[2], v1[3])};
        float s = ((v0[0] * v0[0] + v0[1] * v0[1]) + (v0[2] * v0[2] + v0[3] * v0[3])) + ((v1[0] * v1[0] + v1[1] * v1[1]) + (v1[2] * v1[2] + v1[3] * v1[3]));
        s += __shfl_xor(s, 16); s += __shfl_xor(s, 32);
        LAS float* ex = (LAS float*)(lds + LDS_EX);
        if (fq == 0) ex[fr * 8 + wid] = s;
        __syncthreads();
        if (tid < 16) { const f32x4 e0 = *(const LAS f32x4*)(ex + tid * 8), e1 = *(const LAS f32x4*)(ex + tid * 8 + 4);
            ssout[(size_t)(TX + mb * 16 + tid) * 4 + pn] = ((e0[0] + e0[1]) + (e0[2] + e0[3])) + ((e1[0] + e1[1]) + (e1[2] + e1[3])); }
        __syncthreads();
    }
};

struct Epi3 {
    static constexpr bool PERM = false;
    bf16_t* act; const float* ss; unsigned* mcnt;
    DEV void prefetch(LAS unsigned char* lds, int brow, int par, int tid) const { if (tid < 256) GLDS(ss + (size_t)(brow + tid) * 4, lds + LDS_EX + par * 4096 + tid * 16); }
    DEV void operator()(f32x4 (&acc)[2][2][4][2], int brow, int bcol, LAS unsigned char* lds, int par) const {
        EPI_IDS
#pragma unroll
        for (int ai = 0; ai < 2; ++ai)
#pragma unroll
            for (int m = 0; m < 4; ++m) {
                const int lr = ai * 128 + wr * 64 + m * 16 + fr, row = brow + lr;
                const f32x4 s4 = *(const LAS f32x4*)(lds + LDS_EX + par * 4096 + lr * 16);
                const float rs = rsqrtf(((s4[0] + s4[1]) + (s4[2] + s4[3])) * (1.0f / 1024.0f) + EPS);
                float o[8];
#pragma unroll
                for (int bj = 0; bj < 2; ++bj) {
                    const f32x4 g = acc[ai][bj][m][0] * rs, u = acc[ai][bj][m][1] * rs;
#pragma unroll
                    for (int j = 0; j < 4; ++j) o[bj * 4 + j] = g[j] * __builtin_amdgcn_rcpf(1.0f + __expf(-g[j])) * u[j];
                }
                *(u32x4*)(act + (size_t)row * DFF + (bcol >> 1) + wc * 32 + fq * 8) = pack8(o);
            }
    }
    DEV void skinny(f32x4 a0, f32x4 a1, int mb, int pn, LAS unsigned char*) const {
        EPI_IDS
        const int row = TX + mb * 16 + fr;
        const float rs = row_rs(ss, row);
        const f32x4 g = a0 * rs, u = a1 * rs;
        float o[4];
#pragma unroll
        for (int j = 0; j < 4; ++j) o[j] = g[j] * __builtin_amdgcn_rcpf(1.0f + __expf(-g[j])) * u[j];
        *(u32x2*)(act + (size_t)row * DFF + pn * 128 + (wid & 3) * 32 + fq * 8 + (wid >> 2) * 4) = (u32x2){cvt_pk_bf16(o[0], o[1]), cvt_pk_bf16(o[2], o[3])};
        asm volatile("s_waitcnt vmcnt(0)" ::: "memory");
        __syncthreads();
        if (tid == 0) { __builtin_amdgcn_fence(__ATOMIC_RELEASE, "agent"); asm volatile("s_waitcnt vmcnt(0)" ::: "memory"); (void)__hip_atomic_fetch_add(mcnt, 1u, __ATOMIC_RELAXED, __HIP_MEMORY_SCOPE_AGENT); }
    }
};

struct EpiF {
    static constexpr bool PERM = true;
    bf16_t* mix; int s, k1, L2;
    DEV void prefetch(LAS unsigned char*, int, int, int) const {}
    DEV void operator()(f32x4 (&acc)[2][2][4][2], int brow, int bcol, LAS unsigned char* lds, int) const {
        EPI_IDS
        LAS float* ex = (LAS float*)(lds + LDS_EX);
#pragma unroll
        for (int ai = 0; ai < 2; ++ai)
#pragma unroll
            for (int m = 0; m < 4; ++m) {
                const int lr = ai * 128 + wr * 64 + m * 16 + fr;
                float q = 0.f;
#pragma unroll
                for (int bj = 0; bj < 2; ++bj)
#pragma unroll
                    for (int n = 0; n < 2; ++n) { const f32x4 v = acc[ai][bj][m][n]; q += (v[0] * v[0] + v[1] * v[1]) + (v[2] * v[2] + v[3] * v[3]); }
                q += __shfl_xor(q, 16); q += __shfl_xor(q, 32);
                if (fq == 0) ex[lr * 4 + wc] = q;
            }
        __syncthreads();
#pragma unroll
        for (int ai = 0; ai < 2; ++ai)
#pragma unroll
            for (int m = 0; m < 4; ++m) {
                const int lr = ai * 128 + wr * 64 + m * 16 + fr, k2 = brow + lr;
                const f32x4 e = *(const LAS f32x4*)(ex + lr * 4);
                const float rs = rsqrtf(((e[0] + e[1]) + (e[2] + e[3])) * (1.0f / 256.0f) + EPS);
                if (k2 < L2) {
                    const int row = rowof(s, k1 + 16 * k2);
#pragma unroll
                    for (int bj = 0; bj < 2; ++bj) {
                        const f32x4 v0 = acc[ai][bj][m][0] * rs, v1 = acc[ai][bj][m][1] * rs;
                        u32x4 w; w.x = cvt_pk_bf16(v0[0], v0[1]); w.y = cvt_pk_bf16(v0[2], v0[3]); w.z = cvt_pk_bf16(v1[0], v1[1]); w.w = cvt_pk_bf16(v1[2], v1[3]);
                        *(u32x4*)(mix + (size_t)row * D + 768 + bj * 128 + wc * 32 + fq * 8) = w;
                    }
                }
            }
    }
    DEV void skinny(f32x4 a0, f32x4 a1, LAS unsigned char* lds) const {
        EPI_IDS
        float q = ((a0[0] * a0[0] + a0[1] * a0[1]) + (a0[2] * a0[2] + a0[3] * a0[3])) + ((a1[0] * a1[0] + a1[1] * a1[1]) + (a1[2] * a1[2] + a1[3] * a1[3]));
        q += __shfl_xor(q, 16); q += __shfl_xor(q, 32);
        LAS float* ex = (LAS float*)(lds + LDS_EX);
        if (fq == 0) ex[fr * 8 + wid] = q;
        __syncthreads();
        if (fr == 0) {
            const f32x4 e0 = *(const LAS f32x4*)ex, e1 = *(const LAS f32x4*)(ex + 4);
            const float rs = rsqrtf((((e0[0] + e0[1]) + (e0[2] + e0[3])) + ((e1[0] + e1[1]) + (e1[2] + e1[3]))) * (1.0f / 256.0f) + EPS);
            bf16_t* mp = mix + (size_t)rowof(s, k1 + 16 * (L2 - 1)) * D + 768 + wid * 32 + fq * 4;
            const f32x4 v0 = a0 * rs, v1 = a1 * rs;
            *(u32x2*)mp = (u32x2){cvt_pk_bf16(v0[0], v0[1]), cvt_pk_bf16(v0[2], v0[3])};
            *(u32x2*)(mp + 16) = (u32x2){cvt_pk_bf16(v1[0], v1[1]), cvt_pk_bf16(v1[2], v1[3])};
        }
        __syncthreads();
    }
};


DEV void phase_prologue(const Params& p, LAS unsigned char* lds) {
    unsigned char* ws = p.ws;
    int tid = threadIdx.x; asm volatile("" : "+v"(tid));
    const long gt = (long)blockIdx.x * NT + tid, gs = (long)gridDim.x * NT;
    LAS float* ctab = (LAS float*)lds;
    if (tid < 64) ctab[tid] = cospif((float)tid * (1.0f / 32.0f));
    __syncthreads();
    bf16_t* W1 = (bf16_t*)(ws + WS_W1); bf16_t* W2 = (bf16_t*)(ws + WS_W2); bf16_t* W3 = (bf16_t*)(ws + WS_W3); bf16_t* W4 = (bf16_t*)(ws + WS_W4);
    LAS unsigned char* xl = lds + 1024;
#define XPOSE_STORE4(pieces, dst0, ldk) do { _Pragma("unroll") for (int _q = 0; _q < 4; ++_q) *(LAS u32x4*)(xl + _q * 9216 + ((tid & 63) * 9 + (tid >> 6)) * 16) = (pieces)[_q]; __syncthreads(); \
        const int _r = tid >> 3, _c = tid & 7; _Pragma("unroll") for (int _q = 0; _q < 4; ++_q) { const u32x4 _v = *(const LAS u32x4*)(xl + _q * 9216 + (_r * 9 + _c) * 16); \
        *(u32x4*)((dst0) + (size_t)(_q * 64 + _r) * (ldk) + _c * 8) = _v; } __syncthreads(); } while (0)
    const int nl = tid & 63, k8l = tid >> 6;
    for (int S = blockIdx.x; S < DEPTH * 16 * 6; S += gridDim.x) {
        const int nq = S % 6, kb = (S / 6) % 16, l = S / (6 * 16), k0 = kb * 64 + k8l * 8;
        float v[4][8];
#pragma unroll
        for (int j = 0; j < 8; ++j) { const int k = k0 + j; const float g = p.norm1_g[l * D + k]; const float* src = p.w_in + ((size_t)l * D + k) * NIN0 + nq * 256 + nl;
#pragma unroll
            for (int q = 0; q < 4; ++q) v[q][j] = src[q * 64] * g; }
        u32x4 pc[4];
#pragma unroll
        for (int q = 0; q < 4; ++q) pc[q] = pack8(v[q]);
        XPOSE_STORE4(pc, W1 + ((size_t)l * NZ + nq * 256) * D + kb * 64, D);
    }
    for (int S = blockIdx.x; S < DEPTH * 16 * 4; S += gridDim.x) {
        const int nq = S % 4, kb = (S / 4) % 16, l = S / (4 * 16), k0 = kb * 64 + k8l * 8;
        float v[4][8];
#pragma unroll
        for (int j = 0; j < 8; ++j) { const int k = k0 + j; const float g = p.mix_g[l * D + k]; const float* src = p.w_out + ((size_t)l * D + k) * D + nq * 256 + nl;
#pragma unroll
            for (int q = 0; q < 4; ++q) v[q][j] = src[q * 64] * g; }
        u32x4 pc[4];
#pragma unroll
        for (int q = 0; q < 4; ++q) pc[q] = pack8(v[q]);
        XPOSE_STORE4(pc, W2 + ((size_t)l * D + nq * 256) * D + kb * 64, D);
    }
    for (int S = blockIdx.x; S < DEPTH * 16 * 22; S += gridDim.x) {
        const int pn = S % 22, kb = (S / 22) % 16, l = S / (22 * 16), k0 = kb * 64 + k8l * 8;
        int col[4];
#pragma unroll
        for (int q = 0; q < 4; ++q) { const int rem = q * 64 + nl, bj = rem >> 7, wc = (rem >> 5) & 3, nn = (rem >> 4) & 1, i = rem & 15;
            const int d = pn * 128 + wc * 32 + (i >> 2) * 8 + bj * 4 + (i & 3); col[q] = nn ? DFF + d : d; }
        float v[4][8];
#pragma unroll
        for (int j = 0; j < 8; ++j) { const int k = k0 + j; const float g = p.norm2_g[l * D + k]; const float* src = p.w_gate_up + ((size_t)l * D + k) * NGU;
#pragma unroll
            for (int q = 0; q < 4; ++q) v[q][j] = src[col[q]] * g; }
        u32x4 pc[4];
#pragma unroll
        for (int q = 0; q < 4; ++q) pc[q] = pack8(v[q]);
        XPOSE_STORE4(pc, W3 + ((size_t)l * NGU + pn * 256) * D + kb * 64, D);
    }
    for (int S = blockIdx.x; S < DEPTH * 44 * 4; S += gridDim.x) {
        const int nq = S % 4, kb = (S / 4) % 44, l = S / (4 * 44), k0 = kb * 64 + k8l * 8;
        float v[4][8];
#pragma unroll
        for (int j = 0; j < 8; ++j) { const int k = k0 + j; const float* src = p.w_down + ((size_t)l * DFF + k) * D + nq * 256 + nl;
#pragma unroll
            for (int q = 0; q < 4; ++q) v[q][j] = src[q * 64]; }
        u32x4 pc[4];
#pragma unroll
        for (int q = 0; q < 4; ++q) pc[q] = pack8(v[q]);
        XPOSE_STORE4(pc, W4 + ((size_t)l * D + nq * 256) * DFF + kb * 64, DFF);
    }
#undef XPOSE_STORE4
    {
        float tt[64];
#pragma unroll
        for (int c = 0; c < 64; ++c) { const int jj = ((nl < 33 ? nl : nl - 32) * c) & 63; tt[c] = nl < 33 ? ctab[jj] : -ctab[(jj - 16) & 63]; }
        LAS float* sb = (LAS float*)(lds + 40960);
        for (int S = blockIdx.x; S < DEPTH * 16 * 4; S += gridDim.x) {
            const int hd = S % 4, kb = (S / 4) % 16, l = S / (4 * 16);
#pragma unroll
            for (int j = 0; j < 2; ++j) { const int k = (tid >> 4) + 32 * j, c4 = (tid & 15) * 4;
                *(LAS f32x4*)(sb + k * 64 + c4) = *(const f32x4*)(p.w_in + ((size_t)l * D + kb * 64 + k) * NIN0 + 1536 + hd * 64 + c4); }
            __syncthreads();
            float val[8];
#pragma unroll
            for (int j = 0; j < 8; ++j) {
                const int k = k8l * 8 + j;
                float a = 0.f;
#pragma unroll
                for (int c4 = 0; c4 < 64; c4 += 4) { const f32x4 x = *(const LAS f32x4*)(sb + k * 64 + c4);
#pragma unroll
                    for (int e = 0; e < 4; ++e) a += x[e] * tt[c4 + e]; }
                val[j] = a * p.norm1_g[l * D + kb * 64 + k];
            }
            *(LAS u32x4*)(xl + ((tid & 63) * 9 + (tid >> 6)) * 16) = pack8(val);
            __syncthreads();
            { const int r = tid >> 3, c = tid & 7;
              *(u32x4*)(W1 + ((size_t)l * NZ + 1536 + hd * 64 + r) * D + kb * 64 + c * 8) = *(const LAS u32x4*)(xl + (r * 9 + c) * 16); }
            __syncthreads();
        }
    }
    bf16_t* PW = (bf16_t*)(ws + WS_PW);
    for (long i = gt; i < (long)DEPTH * 4 * 96 * 96; i += gs) {
        const int k = (int)(i % 96), n = (int)((i / 96) % 96), lg = (int)(i / (96 * 96)), l = lg >> 2, g = lg & 3;
        const float v = p.pool_w[((size_t)lg * 96 + k) * 96 + n] * p.pool_scale[l * 384 + g * 96 + n];
        PW[i] = (bf16_t)(cvt_pk_bf16(v, 0.f) & 0xffff);
    }
    bf16_t* DPm = (bf16_t*)(ws + WS_DP); bf16_t* DSm = (bf16_t*)(ws + WS_DS);
    for (long i = gt; i < (long)MPP * KP; i += gs) {
        const int kk = (int)(i % KP), k2 = (int)(i / KP), part = kk / KHP, n2 = kk % KHP;
        float v = 0.f;
        if (k2 < L2P && n2 < L2P) { const float a = (float)(2 * ((k2 * n2) % L2P)) * (1.0f / (float)L2P); v = part == 0 ? cospif(a) : sinpif(a); }
        DPm[i] = (bf16_t)(cvt_pk_bf16(v, 0.f) & 0xffff);
    }
    for (long i = gt; i < (long)MPS * KS; i += gs) {
        const int kk = (int)(i % KS), k2 = (int)(i / KS), part = kk / KHS, n2 = kk % KHS;
        float v = 0.f;
        if (k2 < L2S && n2 < L2S) { const float a = (float)(2 * ((k2 * n2) % L2S)) * (1.0f / (float)L2S); v = part == 0 ? cospif(a) : sinpif(a); }
        DSm[i] = (bf16_t)(cvt_pk_bf16(v, 0.f) & 0xffff);
    }
    f32x2* TWPt = (f32x2*)(ws + WS_TWP); f32x2* TWSt = (f32x2*)(ws + WS_TWS);
    for (long i = gt; i < 16 * KHP; i += gs) {
        const int n2 = (int)(i % KHP), k1 = (int)(i / KHP);
        const float a = (float)(2 * ((k1 * n2) % LP)) * (1.0f / (float)LP), sc = 1.0f / sqrtf(64.0f * (float)LP);
        TWPt[i] = (f32x2){cospif(a) * sc, -sinpif(a) * sc};
    }
    for (long i = gt; i < 16 * KHS; i += gs) {
        const int n2 = (int)(i % KHS), k1 = (int)(i / KHS);
        const float a = (float)(2 * ((k1 * n2) % LS)) * (1.0f / (float)LS), sc = 1.0f / sqrtf(64.0f * (float)LS);
        TWSt[i] = (f32x2){cospif(a) * sc, -sinpif(a) * sc};
    }
    bf16_t* hb = (bf16_t*)(ws + WS_HB); float* ss1 = (float*)(ws + WS_SS1);
    const int lane = tid & 63, gw = (int)(gt >> 6), nw = (int)(gs >> 6);
    for (int r0 = gw * 4; r0 < T; r0 += nw * 4) {
        f32x4 v[4][4];
#pragma unroll
        for (int q = 0; q < 4; ++q) {
            const int r = r0 + q;
            const float* src = r < 16384 ? p.x_prompt + (size_t)r * D : (r < TX ? p.x_sample + (size_t)(r - 16384) * D : p.meta + (size_t)((r - TX) & 15) * D);
#pragma unroll
            for (int j = 0; j < 4; ++j) v[q][j] = *(const f32x4*)(src + j * 256 + lane * 4);
        }
        float s[4];
#pragma unroll
        for (int q = 0; q < 4; ++q) {
            s[q] = 0.f;
#pragma unroll
            for (int j = 0; j < 4; ++j) {
                const f32x4 x = v[q][j];
                u32x2 w; w.x = cvt_pk_bf16(x[0], x[1]); w.y = cvt_pk_bf16(x[2], x[3]);
                *(u32x2*)(hb + (size_t)(r0 + q) * D + j * 256 + lane * 4) = w;
                s[q] += (x[0] * x[0] + x[1] * x[1]) + (x[2] * x[2] + x[3] * x[3]);
            }
        }
#pragma unroll
        for (int o = 32; o >= 1; o >>= 1)
#pragma unroll
            for (int q = 0; q < 4; ++q) s[q] += __shfl_xor(s[q], o);
        if (lane < 4) { const float sv = lane == 0 ? s[0] : (lane == 1 ? s[1] : (lane == 2 ? s[2] : s[3])); *(f32x4*)(ss1 + (size_t)(r0 + lane) * 4) = (f32x4){sv, 0.f, 0.f, 0.f}; }
    }
}

DEV void phase_xb(const Params& p, int it0, int itstep);
DEV void phase_gemm1(const Params& p, int l, LAS unsigned char* lds) {
    unsigned char* ws = p.ws;
    unsigned* vcnt = (unsigned*)(ws + WS_BAR) + VCNT_WORD0 + 64 * l;
    Epi1 e{(bf16_t*)(ws + WS_Z), (const float*)(ws + WS_SS1), vcnt};
    const bf16_t* A = (const bf16_t*)(ws + WS_HB); const bf16_t* B = (const bf16_t*)(ws + WS_W1) + (size_t)l * NZ * D;
    const int G = gridDim.x, b = blockIdx.x;
    const bool tail = (G == 256) ? (b >= 64) : true;
    if (G == 256) { if (b < 63) skinny_item(lds, A, D, B, D, D, b % 9, 6 - b / 9, e); }
    else for (int i = b; i < 9 * 7; i += G) skinny_item(lds, A, D, B, D, D, i % 9, 6 - i / 9, e);
    gemm_loop<0>(lds, A, D, B, D, D, e, b, G, 192 * 7, TileG1{});
    if (tail) {
        int tid = threadIdx.x; asm volatile("" : "+v"(tid));
        if (tid == 0) { unsigned sp = 0; while (__hip_atomic_load(vcnt, __ATOMIC_RELAXED, __HIP_MEMORY_SCOPE_AGENT) < (unsigned)NVTILES) { __builtin_amdgcn_s_sleep(1); if (++sp > (1u << 22)) break; } }
        __syncthreads();
        __builtin_amdgcn_fence(__ATOMIC_ACQUIRE, "agent");
        asm volatile("s_waitcnt vmcnt(0)" ::: "memory");
        if (G == 256) phase_xb(p, b - 64, 192); else phase_xb(p, b, G);
    }
}
DEV void phase_gemm2(const Params& p, int l, LAS unsigned char* lds) {
    unsigned char* ws = p.ws;
    EpiRes e{(bf16_t*)(ws + WS_HB), (float*)(ws + WS_SS2)};
    const bf16_t* A = (const bf16_t*)(ws + WS_MIX); const bf16_t* B = (const bf16_t*)(ws + WS_W2) + (size_t)l * D * D;
    if (l < DEPTH - 1) for (int i = blockIdx.x; i < 9 * 4; i += gridDim.x) skinny_item(lds, A, D, B, D, D, i % 9, i / 9, e);
    gemm_loop<0>(lds, A, D, B, D, D, e, blockIdx.x, gridDim.x, 192 * 4, TileMap{192, 4});
}
DEV void phase_gemm3(const Params& p, int l, LAS unsigned char* lds) {
    unsigned char* ws = p.ws;
    unsigned* mcnt = (unsigned*)(ws + WS_BAR) + MCNT_WORD0 + 64 * l;
    Epi3 e{(bf16_t*)(ws + WS_ACT), (const float*)(ws + WS_SS2), mcnt};
    const bf16_t* A = (const bf16_t*)(ws + WS_HB); const bf16_t* B = (const bf16_t*)(ws + WS_W3) + (size_t)l * NGU * D;
    const int G = gridDim.x, b = blockIdx.x;
    if (l == DEPTH - 1) {}
    else if (G == 256) { if (b >= 128) for (int i = b - 128; i < 9 * 22; i += 128) skinny_item(lds, A, D, B, D, D, i % 9, i / 9, e); }
    else for (int i = b; i < 9 * 22; i += G) skinny_item(lds, A, D, B, D, D, i % 9, i / 9, e);
    gemm_loop<0>(lds, A, D, B, D, D, e, b, G, 192 * 22, TileMap{192, 22});
    if (l < DEPTH - 1 && G == 256 && b >= 220) {
        int tid = threadIdx.x; asm volatile("" : "+v"(tid));
        if (tid == 0) { unsigned sp = 0; while (__hip_atomic_load(mcnt, __ATOMIC_RELAXED, __HIP_MEMORY_SCOPE_AGENT) < 198u) { __builtin_amdgcn_s_sleep(1); if (++sp > (1u << 22)) break; } }
        __syncthreads();
        __builtin_amdgcn_fence(__ATOMIC_ACQUIRE, "agent");
        asm volatile("s_waitcnt vmcnt(0)" ::: "memory");
        EpiRes e4{(bf16_t*)(ws + WS_HB), (float*)(ws + WS_SS1)};
        const int i = b - 220;
        skinny_item(lds, (const bf16_t*)(ws + WS_ACT), DFF, (const bf16_t*)(ws + WS_W4) + (size_t)l * D * DFF, DFF, DFF, i % 9, i / 9, e4);
    }
}
DEV void phase_gemm4(const Params& p, int l, LAS unsigned char* lds) {
    unsigned char* ws = p.ws;
    EpiRes e{(bf16_t*)(ws + WS_HB), (float*)(ws + WS_SS1)};
    const bf16_t* A = (const bf16_t*)(ws + WS_ACT); const bf16_t* B = (const bf16_t*)(ws + WS_W4) + (size_t)l * D * DFF;
    if (l < DEPTH - 1 && gridDim.x != 256) for (int i = blockIdx.x; i < 9 * 4; i += gridDim.x) skinny_item(lds, A, DFF, B, DFF, DFF, i % 9, i / 9, e);
    gemm_loop<0>(lds, A, DFF, B, DFF, DFF, e, blockIdx.x, gridDim.x, 192 * 4, TileMapRev{192, 4});
}
DEV void dft_item(const Params& p, int it, LAS unsigned char* lds) {
    unsigned char* ws = p.ws;
    bf16_t* mix = (bf16_t*)(ws + WS_MIX);
    const bf16_t* wbp = (const bf16_t*)((unsigned char*)p.out + OUT_WBP); const bf16_t* wbs = (const bf16_t*)((unsigned char*)p.out + OUT_WBS);
    if (it < 64) {
        const int pm = it & 3, pn = it >> 2;
        EpiF e{mix, 0, pn, L2P};
        gemm_loop<1>(lds, (const bf16_t*)(ws + WS_DP), KP, wbp, NCP, KP, e, 0, 1, 1, TileOne{pm * 256, pn * 256});
    } else if (it < 192) {
        const int pn = it - 64;
        EpiF e{mix, 1 + (pn >> 4), pn & 15, L2S};
        gemm_loop<1>(lds, (const bf16_t*)(ws + WS_DS), KS, wbs, NCS, KS, e, 0, 1, 1, TileOne{0, pn * 256});
    } else if (it < 208) {
        const int pn = it - 192;
        EpiF e{mix, 0, pn, L2P};
        skinny_dft(lds, (const bf16_t*)(ws + WS_DP), KP, wbp, NCP, KP, L2P - 1, pn * 256, e);
    } else {
        const int pn = it - 208;
        EpiF e{mix, 1 + (pn >> 4), pn & 15, L2S};
        skinny_dft(lds, (const bf16_t*)(ws + WS_DS), KS, wbs, NCS, KS, L2S - 1, pn * 256, e);
    }
}
DEV void phase_dft(const Params& p, LAS unsigned char* lds) {
    const int b = blockIdx.x, G = gridDim.x;
    if (G == 256) {
        if (b < 192) dft_item(p, b, lds);
        else for (int it = b; it < 336; it += 64) dft_item(p, it, lds);
    } else {
        for (int it = b; it < 336; it += G) dft_item(p, it, lds);
    }
}

struct XaTile { int s, p0, np, L; };
DEV XaTile xa_next(int& g0, int g1) {
    XaTile t; t.s = 0; t.p0 = 0; t.np = 0; t.L = 16;
    if (g0 < g1) {
        int gs, gl;
        if (g0 < 1025) { t.s = 0; gs = 0; gl = 1025; } else { const int q = (g0 - 1025) / 257; t.s = 1 + q; gs = 1025 + 257 * q; gl = 257; }
        const int ng = min(4, min(g1, gs + gl) - g0);
        t.p0 = (g0 - gs) * 16; t.np = ng * 16; t.L = gl * 16; g0 += ng;
    }
    return t;
}
DEV void xa_stage_load(const bf16_t* z, const XaTile& t, int tid, u32x4 (&v)[8]) {
    const int nchunk = (t.np + 15) * 48;
#pragma unroll
    for (int j = 0; j < 8; ++j) {
        const int c = tid + j * NT, i = c / 48, cg8 = c % 48, pp = t.p0 - 8 + i;
        v[j] = (u32x4){0u, 0u, 0u, 0u};
        if (t.np > 0 && c < nchunk && pp >= 0 && pp < t.L) v[j] = *(const u32x4*)(z + (size_t)rowof(t.s, pp) * NZ + 1152 + cg8 * 8);
    }
}
struct ConvRegs { u32x4 xa[6], gc[6], gb[4]; };
DEV void xa_conv_load(const bf16_t* z, const XaTile& t, int tb, int lane, ConvRegs& r, int (&rows)[6]) {
#pragma unroll
    for (int i = 0; i < 6; ++i) { const int pp = t.p0 + tb - 1 + i; rows[i] = rowof(t.s, min(max(pp, 0), t.L - 1)); }
    if (tb < t.np && lane < 48) {
        const int c = lane * 8;
#pragma unroll
        for (int i = 0; i < 6; ++i) { const bf16_t* q = z + (size_t)rows[i] * NZ + c; r.xa[i] = *(const u32x4*)q; r.gc[i] = *(const u32x4*)(q + 768); }
#pragma unroll
        for (int k = 0; k < 4; ++k) r.gb[k] = *(const u32x4*)(z + (size_t)rows[k + 1] * NZ + c + 384);
    }
}
DEV void xa_conv_finish(bf16_t* mix, const float* cw, const XaTile& t, int tb, int lane, const ConvRegs& r, const int (&rows)[6]) {
    if (tb >= t.np) return;
    float a[4][8]; float sq[4] = {0.f, 0.f, 0.f, 0.f};
    if (lane < 48) {
        const int c = lane * 8;
        float wv[3][8];
#pragma unroll
        for (int q = 0; q < 3; ++q) { const f32x4 w0 = *(const f32x4*)(cw + q * 384 + c), w1 = *(const f32x4*)(cw + q * 384 + c + 4);
#pragma unroll
            for (int j = 0; j < 4; ++j) { wv[q][j] = w0[j]; wv[q][4 + j] = w1[j]; } }
        float y[6][8];
#pragma unroll
        for (int i = 0; i < 6; ++i) {
            const int pp = t.p0 + tb - 1 + i;
            const float msk = (pp >= 0 && pp < t.L) ? 1.0f : 0.0f;
#pragma unroll
            for (int j = 0; j < 4; ++j) { y[i][2 * j] = bflo(r.xa[i][j]) * bflo(r.gc[i][j]) * msk; y[i][2 * j + 1] = bfhi(r.xa[i][j]) * bfhi(r.gc[i][j]) * msk; }
        }
#pragma unroll
        for (int k = 0; k < 4; ++k)
#pragma unroll
            for (int j = 0; j < 4; ++j) {
                const int e0 = 2 * j, e1 = 2 * j + 1;
                a[k][e0] = bflo(r.gb[k][j]) * (wv[0][e0] * y[k][e0] + wv[1][e0] * y[k + 1][e0] + wv[2][e0] * y[k + 2][e0]);
                a[k][e1] = bfhi(r.gb[k][j]) * (wv[0][e1] * y[k][e1] + wv[1][e1] * y[k + 1][e1] + wv[2][e1] * y[k + 2][e1]);
                sq[k] += a[k][e0] * a[k][e0] + a[k][e1] * a[k][e1];
            }
    } else {
#pragma unroll
        for (int k = 0; k < 4; ++k)
#pragma unroll
            for (int j = 0; j < 8; ++j) a[k][j] = 0.f;
    }
#pragma unroll
    for (int o = 32; o >= 1; o >>= 1)
#pragma unroll
        for (int k = 0; k < 4; ++k) sq[k] += __shfl_xor(sq[k], o);
    if (lane < 48) {
#pragma unroll
        for (int k = 0; k < 4; ++k) {
            const float rs = rsqrtf(sq[k] * (1.0f / 384.0f) + EPS);
#pragma unroll
            for (int j = 0; j < 8; ++j) a[k][j] *= rs;
            *(u32x4*)(mix + (size_t)rows[k + 1] * D + lane * 8) = pack8(a[k]);
        }
    }
}
DEV void lds_row_add(const LAS bf16_t* q, float (&S)[8], float sign) {
    const u32x4 v = *(const LAS u32x4*)q;
#pragma unroll
    for (int j = 0; j < 4; ++j) { S[2 * j] += sign * bflo(v[j]); S[2 * j + 1] += sign * bfhi(v[j]); }
}
#define XA_BAR do { asm volatile("s_waitcnt lgkmcnt(0)" ::: "memory"); __builtin_amdgcn_s_barrier(); } while (0)

DEV void xa_tile(const Params& p, int l, const XaTile& t, const XaTile& tn, u32x4 (&st)[8], LAS unsigned char* lds, const bf16x8 (&bfr)[3][3]) {
    unsigned char* ws = p.ws;
    const bf16_t* z = (const bf16_t*)(ws + WS_Z); bf16_t* mix = (bf16_t*)(ws + WS_MIX);
    const float* cw = p.conv_w + (size_t)l * 3 * 384;
    int tid = threadIdx.x; asm volatile("" : "+v"(tid));
    const int wid = tid >> 6, lane = tid & 63, fr = lane & 15, fq = lane >> 4;
    LAS bf16_t* xs = (LAS bf16_t*)lds;
    LAS bf16_t* pre = (LAS bf16_t*)(lds + 80 * 784);
    LAS float* psum = (LAS float*)(lds + 80 * 784 + 64 * 784);
    const int np = t.np, p0 = t.p0, L = t.L, nchunk = (np + 15) * 48;
    ConvRegs cr; int rows[6];
    xa_conv_load(z, t, wid * 8, lane, cr, rows);
#pragma unroll
    for (int j = 0; j < 8; ++j) { const int c = tid + j * NT, i = c / 48, cg8 = c % 48; if (c < nchunk) *(LAS u32x4*)(xs + i * 392 + cg8 * 8) = st[j]; }
    xa_stage_load(z, tn, tid, st);
    XA_BAR;
    if (tid < 384) {
        const int cg8 = tid % 48, seg = tid / 48, gi = cg8 / 12, left = 1 << gi, right = left - 1, t0 = seg * 8;
        if (t0 < np) {
            const LAS bf16_t* col = xs + cg8 * 8;
            float S[8];
#pragma unroll
            for (int j = 0; j < 8; ++j) S[j] = 0.f;
            for (int q = t0 + 8 - left; q <= t0 + 8 + right; ++q) lds_row_add(col + q * 392, S, 1.0f);
#pragma unroll
            for (int k = 0; k < 8; ++k) {
                const int tt = t0 + k, i = tt + 8, pp = p0 + tt;
                const float inv = 1.0f / (float)(min(pp + right, L - 1) - max(pp - left, 0) + 1);
                float o[8];
#pragma unroll
                for (int j = 0; j < 8; ++j) o[j] = S[j] * inv;
                lds_row_add(col + i * 392, o, -1.0f);
                *(LAS u32x4*)(pre + tt * 392 + cg8 * 8) = pack8(o);
                if (k < 7) { lds_row_add(col + (i + right + 1) * 392, S, 1.0f); lds_row_add(col + (i - left) * 392, S, -1.0f); }
            }
        }
    }
    xa_conv_finish(mix, cw, t, wid * 8, lane, cr, rows);
    xa_conv_load(z, t, wid * 8 + 4, lane, cr, rows);
    XA_BAR;
    const int g = wid >> 1, nbh = wid & 1, nmb = np >> 4;
    f32x4 pacc[4][3];
#pragma unroll
    for (int mb = 0; mb < 4; ++mb)
#pragma unroll
        for (int nb = 0; nb < 3; ++nb) pacc[mb][nb] = (f32x4){0.f, 0.f, 0.f, 0.f};
#pragma unroll
    for (int mb = 0; mb < 4; ++mb) {
        if (mb < nmb) {
#pragma unroll
            for (int ks = 0; ks < 3; ++ks) {
                const bf16x8 af = *(const LAS bf16x8*)(pre + (mb * 16 + fr) * 392 + g * 96 + ks * 32 + fq * 8);
#pragma unroll
                for (int nb = 0; nb < 3; ++nb) pacc[mb][nb] = __builtin_amdgcn_mfma_f32_16x16x32_bf16(bfr[nb][ks], af, pacc[mb][nb], 0, 0, 0);
            }
            float q = 0.f;
#pragma unroll
            for (int nb = 0; nb < 3; ++nb) { const f32x4 v = pacc[mb][nb]; q += (v[0] * v[0] + v[1] * v[1]) + (v[2] * v[2] + v[3] * v[3]); }
            q += __shfl_xor(q, 16); q += __shfl_xor(q, 32);
            if (fq == 0) psum[(mb * 16 + fr) * 8 + wid] = q;
        }
    }
    XA_BAR;
#pragma unroll
    for (int mb = 0; mb < 4; ++mb) {
        if (mb < nmb) {
            const f32x4 e0 = *(const LAS f32x4*)(psum + (mb * 16 + fr) * 8), e1 = *(const LAS f32x4*)(psum + (mb * 16 + fr) * 8 + 4);
            const float rs = rsqrtf((((e0[0] + e0[1]) + (e0[2] + e0[3])) + ((e1[0] + e1[1]) + (e1[2] + e1[3]))) * (1.0f / 384.0f) + EPS);
            const int row = rowof(t.s, p0 + mb * 16 + fr);
#pragma unroll
            for (int nb = 0; nb < 3; ++nb) {
                const f32x4 v = pacc[mb][nb] * rs;
                u32x2 w; w.x = cvt_pk_bf16(v[0], v[1]); w.y = cvt_pk_bf16(v[2], v[3]);
                *(u32x2*)(mix + (size_t)row * D + 384 + g * 96 + (nbh * 3 + nb) * 16 + fq * 4) = w;
            }
        }
    }
    xa_conv_finish(mix, cw, t, wid * 8 + 4, lane, cr, rows);
    XA_BAR;
}

DEV void phase_xa(const Params& p, int l, LAS unsigned char* lds) {
    int g0, g1;
    if (gridDim.x == 256) {
        const int b = blockIdx.x, b1 = b + 1;
        const int c0 = b < 64 ? 60 * b : (b < 192 ? 3840 + 140 * (b - 64) : 21760 + 143 * (b - 192));
        const int c1 = b1 < 64 ? 60 * b1 : (b1 < 192 ? 3840 + 140 * (b1 - 64) : 21760 + 143 * (b1 - 192));
        g0 = (int)((long)c0 * NGROUPS / 30912); g1 = (int)((long)c1 * NGROUPS / 30912);
    } else { g0 = (int)((long)blockIdx.x * NGROUPS / gridDim.x); g1 = (int)((long)(blockIdx.x + 1) * NGROUPS / gridDim.x); }
    int tid = threadIdx.x; asm volatile("" : "+v"(tid));
    bf16x8 bfr[3][3];
    {
        const int wid = tid >> 6, lane = tid & 63, fr = lane & 15, fq = lane >> 4, g = wid >> 1, nbh = wid & 1;
        const bf16_t* pw = (const bf16_t*)(p.ws + WS_PW) + (size_t)l * 4 * 96 * 96;
#pragma unroll
        for (int nb = 0; nb < 3; ++nb)
#pragma unroll
            for (int ks = 0; ks < 3; ++ks) bfr[nb][ks] = *(const bf16x8*)(pw + ((size_t)g * 96 + (nbh * 3 + nb) * 16 + fr) * 96 + ks * 32 + fq * 8);
    }
    const bf16_t* z = (const bf16_t*)(p.ws + WS_Z);
    XaTile t = xa_next(g0, g1);
    u32x4 st[8];
    xa_stage_load(z, t, tid, st);
    while (t.np > 0) {
        const XaTile tn = xa_next(g0, g1);
        xa_tile(p, l, t, tn, st, lds, bfr);
        t = tn;
    }
    asm volatile("s_waitcnt vmcnt(0)" ::: "memory");
    __syncthreads();
}

DEV void dft4(float& ar, float& ai, float& br, float& bi, float& cr, float& ci, float& dr, float& di) {
    const float s0r = ar + cr, s0i = ai + ci, d0r = ar - cr, d0i = ai - ci;
    const float s1r = br + dr, s1i = bi + di, d1r = br - dr, d1i = bi - di;
    ar = s0r + s1r; ai = s0i + s1i; cr = s0r - s1r; ci = s0i - s1i;
    br = d0r + d1i; bi = d0i - d1r; dr = d0r - d1i; di = d0i + d1r;
}
DEV void cmulc(float& r, float& i, float c, float s) { const float tr = r * c - i * s, ti = r * s + i * c; r = tr; i = ti; }

DEV void phase_xb(const Params& p, int it0, int itstep) {
    unsigned char* ws = p.ws;
    const bf16_t* z = (const bf16_t*)(ws + WS_Z);
    int tid = threadIdx.x; asm volatile("" : "+v"(tid));
    const int m = tid & 255, half = tid >> 8;
    const int hdc = 1536 + (m >> 6) * 64, ml = m & 63;
    const int cre = hdc + (ml <= 32 ? ml : 64 - ml);
    const int cim = hdc + 32 + ((ml & 31) == 0 ? 1 : (ml < 32 ? ml : 64 - ml));
    const float sgn = (ml & 31) == 0 ? 0.f : (ml < 32 ? 1.f : -1.f);
    for (int it = it0; it < 136 + 8 * 40; it += itstep) {
        int s, gq, L2, KH, N, colbase; const f32x2* tw; bf16_t* wb;
        if (it < 136) { s = 0; gq = it; L2 = L2P; KH = KHP; N = NCP; colbase = 0; tw = (const f32x2*)(ws + WS_TWP); wb = (bf16_t*)((unsigned char*)p.out + OUT_WBP); }
        else { const int j = it - 136; s = 1 + j / 40; gq = j % 40; L2 = L2S; KH = KHS; N = NCS; colbase = (s - 1) * 4096; tw = (const f32x2*)(ws + WS_TWS); wb = (bf16_t*)((unsigned char*)p.out + OUT_WBS); }
        unsigned outr[16][2], outi[16][2];
        bf16_t raw[2][32];
#define XB_LOAD(set, idx) do { const int _n2 = 8 * gq + 4 * half + (idx); \
            if (_n2 < L2) { _Pragma("unroll") for (int n1 = 0; n1 < 16; ++n1) { const bf16_t* q = z + (size_t)rowof(s, L2 * n1 + _n2) * NZ; raw[set][2 * n1] = q[cre]; raw[set][2 * n1 + 1] = q[cim]; } } \
            else { _Pragma("unroll") for (int n1 = 0; n1 < 32; ++n1) raw[set][n1] = 0; } } while (0)
        XB_LOAD(0, 0);
        float pr[2][16], pi[2][16];
#pragma unroll
        for (int idx = 0; idx < 4; ++idx) {
            const int i2 = idx >> 1, i1 = idx & 1, set = idx & 1;
            if (idx < 3) XB_LOAD(set ^ 1, idx + 1);
            SCHED;
            {
                const int n2 = 8 * gq + 4 * half + idx;
                float xr[16], xi[16];
                if (n2 < L2) {
#pragma unroll
                    for (int n1 = 0; n1 < 16; ++n1) { xr[n1] = bf2f(raw[set][2 * n1]); xi[n1] = bf2f(raw[set][2 * n1 + 1]) * sgn; }
#pragma unroll
                    for (int b = 0; b < 4; ++b) dft4(xr[b], xi[b], xr[4 + b], xi[4 + b], xr[8 + b], xi[8 + b], xr[12 + b], xi[12 + b]);
                    const float C1 = 0.92387953251128674f, S1 = 0.38268343236508977f, R2 = 0.70710678118654752f;
                    cmulc(xr[5], xi[5], C1, -S1);
                    cmulc(xr[6], xi[6], R2, -R2);
                    cmulc(xr[7], xi[7], S1, -C1);
                    cmulc(xr[9], xi[9], R2, -R2);
                    cmulc(xr[10], xi[10], 0.f, -1.f);
                    cmulc(xr[11], xi[11], -R2, -R2);
                    cmulc(xr[13], xi[13], S1, -C1);
                    cmulc(xr[14], xi[14], -R2, -R2);
                    cmulc(xr[15], xi[15], -C1, S1);
#pragma unroll
                    for (int c = 0; c < 4; ++c) dft4(xr[4 * c], xi[4 * c], xr[4 * c + 1], xi[4 * c + 1], xr[4 * c + 2], xi[4 * c + 2], xr[4 * c + 3], xi[4 * c + 3]);
#pragma unroll
                    for (int c = 0; c < 4; ++c)
#pragma unroll
                        for (int d = 0; d < 4; ++d) {
                            const int k1 = c + 4 * d;
                            const f32x2 t2 = tw[k1 * KH + n2];
                            const float r = xr[4 * c + d], i = xi[4 * c + d];
                            pr[i1][k1] = r * t2[0] - i * t2[1]; pi[i1][k1] = r * t2[1] + i * t2[0];
                        }
                } else {
#pragma unroll
                    for (int k1 = 0; k1 < 16; ++k1) { pr[i1][k1] = 0.f; pi[i1][k1] = 0.f; }
                }
            }
            if (i1 == 1) {
#pragma unroll
                for (int k1 = 0; k1 < 16; ++k1) { outr[k1][i2] = cvt_pk_bf16(pr[0][k1], pr[1][k1]); outi[k1][i2] = cvt_pk_bf16(pi[0][k1], pi[1][k1]); }
            }
        }
#undef XB_LOAD
#pragma unroll
        for (int k1 = 0; k1 < 16; ++k1) {
            const size_t col = (size_t)colbase + k1 * 256 + m;
            *(u32x2*)(wb + ((size_t)gq * N + col) * 8 + half * 4) = (u32x2){outr[k1][0], outr[k1][1]};
            *(u32x2*)(wb + ((size_t)(KH / 8 + gq) * N + col) * 8 + half * 4) = (u32x2){outi[k1][0], outi[k1][1]};
        }
    }
}

DEV void phase_final(const Params& p) {
    const float* ss = (const float*)(p.ws + WS_SS1);
    const bf16_t* hb = (const bf16_t*)(p.ws + WS_HB);
    int tid = threadIdx.x; asm volatile("" : "+v"(tid));
    const int lane = tid & 63;
    const int gw = (int)(((long)blockIdx.x * NT + tid) >> 6), nw = (int)(((long)gridDim.x * NT) >> 6);
    const f32x4 g00 = *(const f32x4*)(p.final_g + lane * 8), g01 = *(const f32x4*)(p.final_g + lane * 8 + 4);
    const f32x4 g10 = *(const f32x4*)(p.final_g + 512 + lane * 8), g11 = *(const f32x4*)(p.final_g + 512 + lane * 8 + 4);
    for (int r0 = gw * 2; r0 < TX; r0 += nw * 2) {
        u32x4 h[2][2]; float rs[2];
#pragma unroll
        for (int q = 0; q < 2; ++q) {
            rs[q] = row_rs(ss, r0 + q);
#pragma unroll
            for (int j = 0; j < 2; ++j) h[q][j] = *(const u32x4*)(hb + (size_t)(r0 + q) * D + j * 512 + lane * 8);
        }
#pragma unroll
        for (int q = 0; q < 2; ++q) {
            float* o = p.out + (size_t)(r0 + q) * D + lane * 8;
            const float s0 = rs[q];
            *(f32x4*)(o) = (f32x4){bflo(h[q][0].x) * s0 * g00[0], bfhi(h[q][0].x) * s0 * g00[1], bflo(h[q][0].y) * s0 * g00[2], bfhi(h[q][0].y) * s0 * g00[3]};
            *(f32x4*)(o + 4) = (f32x4){bflo(h[q][0].z) * s0 * g01[0], bfhi(h[q][0].z) * s0 * g01[1], bflo(h[q][0].w) * s0 * g01[2], bfhi(h[q][0].w) * s0 * g01[3]};
            *(f32x4*)(o + 512) = (f32x4){bflo(h[q][1].x) * s0 * g10[0], bfhi(h[q][1].x) * s0 * g10[1], bflo(h[q][1].y) * s0 * g10[2], bfhi(h[q][1].y) * s0 * g10[3]};
            *(f32x4*)(o + 516) = (f32x4){bflo(h[q][1].z) * s0 * g11[0], bfhi(h[q][1].z) * s0 * g11[1], bflo(h[q][1].w) * s0 * g11[2], bfhi(h[q][1].w) * s0 * g11[3]};
        }
    }
}

#define XB_TMO      128
#define XB_XCNT(j)  (256  + 64 * (j))
#define XB_XSUB(j)  (1280 + 64 * (j))
#define XB_XGEN(j)  (2304 + 64 * (j))
#define XB_TOP      3328
#define XB_TOPGEN   3392
#define XCD_BAR_WORDS 3456
#define XB_SPIN_CAP (1u << 18)
DEV unsigned xb_ld(unsigned* p) { return __hip_atomic_load(p, __ATOMIC_RELAXED, __HIP_MEMORY_SCOPE_AGENT); }
DEV unsigned xb_add(unsigned* p, unsigned v) { return __hip_atomic_fetch_add(p, v, __ATOMIC_RELAXED, __HIP_MEMORY_SCOPE_AGENT); }
DEV unsigned xb_xcc_id() { return (unsigned)__builtin_amdgcn_s_getreg((3 << 11) | 20) & 0xFu; }
#define XB_SPIN(cond, bar) do { unsigned _sp = 0; while (cond) { __builtin_amdgcn_s_sleep(1); \
    if ((++_sp & 255u) == 0u) { if (xb_ld(&(bar)[XB_TMO])) break; if (_sp > XB_SPIN_CAP) { atomicAdd(&(bar)[XB_TMO], 1u); break; } } } } while (0)
struct XcdBarrier { unsigned* bar; unsigned x; volatile LAS unsigned* st; };
DEV XcdBarrier xcd_barrier_post(unsigned* bar, volatile LAS unsigned* st) {
    XcdBarrier b; b.bar = bar; b.x = xb_xcc_id(); b.st = st;
    if (threadIdx.x == 0) (void)xb_add(&bar[XB_XCNT(b.x)], 1u);
    return b;
}
DEV void xcd_barrier_complete(unsigned* bar, unsigned x, unsigned& nloc, unsigned& nx) {
    const unsigned G = gridDim.x * gridDim.y * gridDim.z;
    unsigned sum, cnt, mine, sp = 0u;
    for (;;) {
        sum = 0u; cnt = 0u; mine = 0u;
#pragma unroll
        for (unsigned j = 0; j < 16; ++j) { const unsigned c = xb_ld(&bar[XB_XCNT(j)]); sum += c; cnt += (c > 0u) ? 1u : 0u; mine = (j == x) ? c : mine; }
        if (sum == G) break;
        __builtin_amdgcn_s_sleep(1);
        if ((++sp & 255u) == 0u) { if (xb_ld(&bar[XB_TMO])) break; if (sp > XB_SPIN_CAP) { atomicAdd(&bar[XB_TMO], 1u); break; } }
    }
    nloc = mine > 0u ? mine : 1u; nx = cnt > 0u ? cnt : 1u;
}
DEV void xcd_barrier(const XcdBarrier& b) {
    asm volatile("s_waitcnt vmcnt(0)" ::: "memory");
    __syncthreads();
    if (threadIdx.x == 0) {
        unsigned* bar = b.bar;
        __builtin_amdgcn_s_waitcnt(0);
        unsigned nloc = b.st[0], nx = b.st[1];
        if (nloc == 0u) { xcd_barrier_complete(bar, b.x, nloc, nx); b.st[0] = nloc; b.st[1] = nx; }
        const unsigned old = xb_add(&bar[XB_XSUB(b.x)], 1u);
        const unsigned gen = old / nloc;
        if (old + 1u == (gen + 1u) * nloc) {
            __builtin_amdgcn_fence(__ATOMIC_RELEASE, "agent");
            asm volatile("s_waitcnt vmcnt(0)" ::: "memory");
            const unsigned og = xb_add(&bar[XB_TOP], 1u);
            const unsigned tg = og / nx;
            if (og + 1u == (tg + 1u) * nx) xb_add(&bar[XB_TOPGEN], 1u);
            else XB_SPIN(xb_ld(&bar[XB_TOPGEN]) == tg, bar);
            __builtin_amdgcn_fence(__ATOMIC_ACQUIRE, "agent");
            xb_add(&bar[XB_XGEN(b.x)], 1u);
            asm volatile("s_waitcnt vmcnt(0)" ::: "memory");
        } else {
            XB_SPIN(xb_ld(&bar[XB_XGEN(b.x)]) == gen, bar);
            __builtin_amdgcn_fence(__ATOMIC_ACQUIRE, "agent");
            asm volatile("s_waitcnt vmcnt(0)" ::: "memory");
        }
    }
    __syncthreads();
}

#if MEGA
__global__ void __launch_bounds__(NT, 2) fwd_mega(Params p) {
    extern __shared__ __attribute__((aligned(16))) unsigned char lds_raw[];
    LAS unsigned char* lds = (LAS unsigned char*)lds_raw;
    cg::grid_group grid = cg::this_grid();
    if (threadIdx.x < 4) ((LAS unsigned*)(lds + LDS_CTL))[threadIdx.x] = 0u;
    __syncthreads();
    XcdBarrier bar = xcd_barrier_post((unsigned*)(p.ws + WS_BAR), (volatile LAS unsigned*)(lds + LDS_CTL));
    phase_prologue(p, lds);
    if (p.ws == nullptr) grid.sync();
    xcd_barrier(bar);
    for (int l = 0; l < DEPTH; ++l) {
        phase_gemm1(p, l, lds); xcd_barrier(bar);
        phase_dft(p, lds); phase_xa(p, l, lds); xcd_barrier(bar);
        phase_gemm2(p, l, lds); xcd_barrier(bar);
        phase_gemm3(p, l, lds); xcd_barrier(bar);
        phase_gemm4(p, l, lds); xcd_barrier(bar);
    }
    phase_final(p);
}
#else
template <int PH> __global__ void __launch_bounds__(NT, 2) phase_kernel(Params p, int l) {
    extern __shared__ __attribute__((aligned(16))) unsigned char lds_raw[];
    LAS unsigned char* lds = (LAS unsigned char*)lds_raw;
    if (PH == 0) phase_prologue(p, lds);
    if (PH == 1) phase_gemm1(p, l, lds);
    if (PH == 2) {}
    if (PH == 3) { phase_dft(p, lds); phase_xa(p, l, lds); }
    if (PH == 4) phase_gemm2(p, l, lds);
    if (PH == 5) phase_gemm3(p, l, lds);
    if (PH == 6) phase_gemm4(p, l, lds);
    if (PH == 7) phase_final(p);
}
template <int PH> static void launch_phase(const Params& p, int l, hipStream_t stream) {
    static bool attr = false;
    if (!attr) { (void)hipFuncSetAttribute((const void*)phase_kernel<PH>, hipFuncAttributeMaxDynamicSharedMemorySize, LDS_BYTES); attr = true; }
    hipLaunchKernelGGL(phase_kernel<PH>, dim3(256), dim3(NT), LDS_BYTES, stream, p, l);
}
#endif

extern "C" void kernel_launch(void* const* d_in, const int* in_sizes, int n_in, void* d_out, int out_size, void* d_ws, size_t ws_size, hipStream_t stream) {
    if (n_in != 14 || ws_size < WS_END || out_size != TX * D) { fprintf(stderr, "kernel_launch: unexpected shapes (n_in %d, ws %zu need %zu, out %d)\n", n_in, ws_size, (size_t)WS_END, out_size); return; }
    Params p{};
    p.x_prompt = (const float*)d_in[0]; p.x_sample = (const float*)d_in[1]; p.meta = (const float*)d_in[2]; p.norm1_g = (const float*)d_in[3];
    p.w_in = (const float*)d_in[4]; p.conv_w = (const float*)d_in[5]; p.pool_w = (const float*)d_in[6]; p.pool_scale = (const float*)d_in[7];
    p.mix_g = (const float*)d_in[8]; p.w_out = (const float*)d_in[9]; p.norm2_g = (const float*)d_in[10]; p.w_gate_up = (const float*)d_in[11];
    p.w_down = (const float*)d_in[12]; p.final_g = (const float*)d_in[13];
    p.out = (float*)d_out; p.ws = (unsigned char*)d_ws;
#if MEGA
    static int grid = 0;
    if (grid == 0) {
        int dev = 0, cus = 0, per_cu = 0;
        (void)hipGetDevice(&dev);
        (void)hipDeviceGetAttribute(&cus, hipDeviceAttributeMultiprocessorCount, dev);
        (void)hipFuncSetAttribute((const void*)fwd_mega, hipFuncAttributeMaxDynamicSharedMemorySize, LDS_BYTES);
        (void)hipOccupancyMaxActiveBlocksPerMultiprocessor(&per_cu, (const void*)fwd_mega, NT, LDS_BYTES);
        if (per_cu < 1) per_cu = 1;
        grid = cus * per_cu;
        if (grid > 256) grid = 256;
    }
    (void)hipMemsetAsync((unsigned char*)d_ws + WS_BAR, 0, XCD_BAR_WORDS_C * 4, stream);
    void* args[] = {&p};
    hipError_t e = hipLaunchCooperativeKernel((const void*)fwd_mega, dim3(grid), dim3(NT), args, LDS_BYTES, stream);
    if (e != hipSuccess) fprintf(stderr, "cooperative launch failed: %s (grid %d)\n", hipGetErrorString(e), grid);
#else
    launch_phase<0>(p, 0, stream);
    for (int l = 0; l < DEPTH; ++l) {
        launch_phase<1>(p, l, stream); launch_phase<2>(p, l, stream); launch_phase<3>(p, l, stream);
        launch_phase<4>(p, l, stream); launch_phase<5>(p, l, stream); launch_phase<6>(p, l, stream);
    }
    launch_phase<7>(p, 0, stream);
#endif
}
```

```cpp
#include <hip/hip_runtime.h>
#include <hip/hip_cooperative_groups.h>
#include <cstdio>
#include <cstdint>
namespace cg = cooperative_groups;

#ifndef MEGA
#define MEGA 1
#endif

#define LAS __attribute__((address_space(3)))
#define DEV __device__ __forceinline__
typedef unsigned short bf16_t;
typedef short bf16x8 __attribute__((ext_vector_type(8)));
typedef float f32x4 __attribute__((ext_vector_type(4)));
typedef float f32x2 __attribute__((ext_vector_type(2)));
typedef unsigned u32x4 __attribute__((ext_vector_type(4)));
typedef unsigned u32x2 __attribute__((ext_vector_type(2)));

constexpr int D = 1024, NZ = 2048, DFF = 2816, NGU = 5632, DEPTH = 4, NIN0 = 1792;
constexpr int TX = 49152, TMETA = 144, T = TX + TMETA, TP = TX + 256;
constexpr int LP = 16400, LS = 4112, L2P = 1025, L2S = 257;
constexpr int KHP = 1088, KHS = 320, KP = 2 * KHP, KS = 2 * KHS, MPP = 1280, MPS = 512;
constexpr int NCP = 4096, NCS = 32768;
constexpr int NGROUPS = 3081;
constexpr float EPS = 1e-6f;
constexpr int LDS_BYTES = 131072 + 8192 + 16;
constexpr int NT = 512;
constexpr int XCD_BAR_WORDS_C = 3456 + 256;
constexpr int VCNT_WORD0 = 3456;
constexpr int MCNT_WORD0 = 3456 + 32;
constexpr int NVTILES = 192 + 9;
constexpr int LDS_EX = 131072;
constexpr int LDS_CTL = 131072 + 8192;

constexpr size_t al(size_t x) { return (x + 255) & ~size_t(255); }
constexpr size_t WS_W1 = 0;
constexpr size_t WS_W2 = WS_W1 + al((size_t)DEPTH * NZ * D * 2);
constexpr size_t WS_W3 = WS_W2 + al((size_t)DEPTH * D * D * 2);
constexpr size_t WS_W4 = WS_W3 + al((size_t)DEPTH * NGU * D * 2);
constexpr size_t WS_PW = WS_W4 + al((size_t)DEPTH * D * DFF * 2);
constexpr size_t WS_DP = WS_PW + al((size_t)DEPTH * 4 * 96 * 96 * 2);
constexpr size_t WS_DS = WS_DP + al((size_t)MPP * KP * 2);
constexpr size_t WS_TWP = WS_DS + al((size_t)MPS * KS * 2);
constexpr size_t WS_TWS = WS_TWP + al((size_t)16 * KHP * 8);
constexpr size_t WS_SS1 = WS_TWS + al((size_t)16 * KHS * 8);
constexpr size_t WS_SS2 = WS_SS1 + al((size_t)TP * 4 * 4);
constexpr size_t WS_HM = WS_SS2 + al((size_t)TP * 4 * 4);
constexpr size_t WS_HB = WS_HM + al((size_t)256 * D * 4);
constexpr size_t WS_Z = WS_HB + al((size_t)TP * D * 2);
constexpr size_t WS_MIX = WS_Z + al((size_t)TP * NZ * 2);
constexpr size_t WS_BAR = WS_MIX + al((size_t)TP * D * 2);
constexpr size_t WS_END = WS_BAR + al((size_t)XCD_BAR_WORDS_C * 4);
constexpr size_t OUT_WBP = 0;
constexpr size_t OUT_WBS = (size_t)KP * NCP * 2;
constexpr size_t WS_ACT = WS_Z;
static_assert((size_t)KP * NCP * 2 + (size_t)KS * NCS * 2 <= (size_t)TX * D * 4, "WB in d_out");
static_assert((size_t)TP * DFF * 2 <= (WS_BAR - WS_Z), "ACT overlay");

struct Params {
    const float *x_prompt, *x_sample, *meta, *norm1_g, *w_in, *conv_w, *pool_w, *pool_scale, *mix_g, *w_out, *norm2_g, *w_gate_up, *w_down, *final_g;
    float* out; unsigned char* ws;
};

DEV unsigned cvt_pk_bf16(float lo, float hi) { unsigned r; asm("v_cvt_pk_bf16_f32 %0, %1, %2" : "=v"(r) : "v"(lo), "v"(hi)); return r; }
DEV float bflo(unsigned w) { return __uint_as_float(w << 16); }
DEV float bfhi(unsigned w) { return __uint_as_float(w & 0xffff0000u); }
DEV float bf2f(bf16_t v) { return __uint_as_float((unsigned)v << 16); }

DEV u32x4 pack8(const float (&v)[8]) { u32x4 w; w.x = cvt_pk_bf16(v[0], v[1]); w.y = cvt_pk_bf16(v[2], v[3]); w.z = cvt_pk_bf16(v[4], v[5]); w.w = cvt_pk_bf16(v[6], v[7]); return w; }

typedef __amdgpu_buffer_rsrc_t rsrc_t;
DEV rsrc_t make_rsrc(const void* base, unsigned bytes) { return __builtin_amdgcn_make_buffer_rsrc((void*)base, 0, (int)bytes, 0x00020000); }
DEV void st16_wt(rsrc_t r, unsigned byte_off, u32x4 v) { __builtin_amdgcn_raw_buffer_store_b128(v, r, byte_off, 0, 16); }

DEV int seq_xbase(int s) { return s == 0 ? 0 : 16384 + 4096 * (s - 1); }
DEV int rowof(int s, int p) { return p < 16 ? TX + 16 * s + p : seq_xbase(s) + p - 16; }

DEV int swz_off(int fr, int fq) { int ob = fr * 64 + fq * 16; return ob ^ (((ob >> 9) & 1) << 5); }
DEV void stage_rc(int b, int& R, int& C) { int st = b >> 10, sb = b & 1023, swz = sb ^ (((sb >> 9) & 1) << 5); R = (st >> 1) * 16 + (swz >> 6); C = (st & 1) * 32 + ((swz & 63) >> 1); }

#define GLDS(g, l) __builtin_amdgcn_global_load_lds((const unsigned*)(g), (LAS unsigned*)(l), 16, 0, 0)
#define WAIT_V(n) asm volatile("s_waitcnt vmcnt(" #n ")" ::: "memory")
#define WAIT_L(n) asm volatile("s_waitcnt lgkmcnt(" #n ")" ::: "memory")
#define BAR __builtin_amdgcn_s_barrier()
#define SCHED __builtin_amdgcn_sched_barrier(0)

template <int BMODE, class Epi, class TileFn>
DEV void gemm_loop(LAS unsigned char* lds, const bf16_t* __restrict__ A, int lda, const bf16_t* __restrict__ B, int ldb, int K, const Epi& epi, int t0, int tstep, int tend, const TileFn& tf) {
    if (t0 >= tend) return;
    int tid = threadIdx.x; asm volatile("" : "+v"(tid));
    const int wid = tid >> 6, lane = tid & 63, wr = wid >> 2, wc = wid & 3, fr = lane & 15, fq = lane >> 4;
    int r0, c0; stage_rc(tid * 16, r0, c0);
    const unsigned voa0 = (unsigned)(r0 * lda + c0) * 2u, voa1 = voa0 + (unsigned)(64 * lda) * 2u;
    const size_t ahalf = (size_t)128 * lda * 2;
    unsigned vob0, vob1; size_t bks, bhalf;
    const int r0b = Epi::PERM ? ((r0 & ~31) + 8 * ((r0 & 15) >> 2) + 4 * ((r0 >> 4) & 1) + (r0 & 3)) : r0;
    if (BMODE == 0) { vob0 = (unsigned)(r0b * ldb + c0) * 2u; vob1 = vob0 + (unsigned)(64 * ldb) * 2u; bks = 128; bhalf = (size_t)128 * ldb * 2; }
    else { vob0 = (unsigned)((c0 >> 3) * ldb + r0b) * 16u; vob1 = vob0 + 64u * 16u; bks = (size_t)ldb * 128; bhalf = 128 * 16; }
    LAS unsigned char* lw = lds + tid * 16;
    const int sw = swz_off(fr, fq);
    LAS unsigned char* la = lds + wr * 8192 + sw;
    LAS unsigned char* lb = lds + 65536 + wc * 4096 + sw;
    int brow, bcol; tf(t0, brow, bcol);
    const char* cA = (const char*)(A + (size_t)brow * lda);
    const char* cB = BMODE == 0 ? (const char*)(B + (size_t)bcol * ldb) : (const char*)(B + (size_t)bcol * 8);

#define STG_A(b, h, ptr) do { const char* _g = (ptr) + (h) * ahalf; LAS unsigned char* _l = lw + ((b) * 2 + (h)) * 16384; GLDS(_g + voa0, _l); GLDS(_g + voa1, _l + 8192); } while (0)
#define STG_B(b, h, ptr) do { const char* _g = (ptr) + (h) * bhalf; LAS unsigned char* _l = lw + 65536 + ((b) * 2 + (h)) * 16384; GLDS(_g + vob0, _l); GLDS(_g + vob1, _l + 8192); } while (0)
#define LDA(dst, b, h) _Pragma("unroll") for (int m = 0; m < 4; ++m) _Pragma("unroll") for (int k = 0; k < 2; ++k) dst[m][k] = *(const LAS bf16x8*)(la + ((b) * 2 + (h)) * 16384 + m * 2048 + k * 1024)
#define LDB(dst, b, h) _Pragma("unroll") for (int n = 0; n < 2; ++n) _Pragma("unroll") for (int k = 0; k < 2; ++k) dst[n][k] = *(const LAS bf16x8*)(lb + ((b) * 2 + (h)) * 16384 + n * 2048 + k * 1024)
#define MMA(ai, bj, Af, Bf) do { __builtin_amdgcn_s_setprio(1); \
    _Pragma("unroll") for (int m = 0; m < 4; ++m) _Pragma("unroll") for (int n = 0; n < 2; ++n) _Pragma("unroll") for (int k = 0; k < 2; ++k) \
        acc[ai][bj][m][n] = __builtin_amdgcn_mfma_f32_16x16x32_bf16(Bf[n][k], Af[m][k], acc[ai][bj][m][n], 0, 0, 0); \
    __builtin_amdgcn_s_setprio(0); } while (0)

    const int nt = K / 64;
    f32x4 acc[2][2][4][2];
#pragma unroll
    for (int a = 0; a < 2; ++a)
#pragma unroll
        for (int b = 0; b < 2; ++b)
#pragma unroll
            for (int m = 0; m < 4; ++m)
#pragma unroll
                for (int n = 0; n < 2; ++n) acc[a][b][m][n] = (f32x4){0.f, 0.f, 0.f, 0.f};
    bf16x8 At[4][2], B0[2][2], B1[2][2];
    STG_B(0, 0, cB); STG_B(0, 1, cB); STG_A(0, 0, cA); STG_A(0, 1, cA);
    if (wr == 1) BAR;
    WAIT_V(2); BAR;
    STG_B(1, 0, cB + bks); STG_A(1, 0, cA + 128); STG_B(1, 1, cB + bks);
    WAIT_V(6); BAR;
    int par = 0;
    for (int tt = t0;; tt += tstep, par ^= 1) {
        const bool has_next = tt + tstep < tend;
        epi.prefetch(lds, brow, par, tid);
        int nrow = brow, ncol = bcol;
        if (has_next) tf(tt + tstep, nrow, ncol);
        const char* nA = (const char*)(A + (size_t)nrow * lda);
        const char* nB = BMODE == 0 ? (const char*)(B + (size_t)ncol * ldb) : (const char*)(B + (size_t)ncol * 8);
        for (int t = 0; t < nt; t += 2) {
            const bool last = (t == nt - 2);
            const char* a1 = cA + (size_t)(t + 1) * 128;
            const char* a2 = last ? nA : cA + (size_t)(t + 2) * 128;
            const char* b2 = last ? nB : cB + (size_t)(t + 2) * bks;
            const char* a3 = a2 + 128; const char* b3 = b2 + bks;
            LDB(B0, 0, 0); LDB(B1, 0, 1); SCHED; LDA(At, 0, 0); STG_A(1, 1, a1);
            WAIT_V(8); WAIT_L(0); BAR; MMA(0, 0, At, B0); MMA(0, 1, At, B1); BAR; SCHED;
            LDA(At, 0, 1); STG_B(0, 0, b2); STG_B(0, 1, b2); STG_A(0, 0, a2);
            WAIT_V(8); WAIT_L(0); BAR; MMA(1, 0, At, B0); MMA(1, 1, At, B1); BAR; SCHED;
            LDB(B0, 1, 0); LDB(B1, 1, 1); SCHED; LDA(At, 1, 0); STG_A(0, 1, a2);
            WAIT_V(8); WAIT_L(0); BAR; MMA(0, 0, At, B0); MMA(0, 1, At, B1); BAR; SCHED;
            LDA(At, 1, 1); STG_B(1, 0, b3); STG_B(1, 1, b3); STG_A(1, 0, a3);
            WAIT_V(8); WAIT_L(0); BAR; MMA(1, 0, At, B0); MMA(1, 1, At, B1); BAR; SCHED;
        }
        if (wr == 0) BAR;
        epi(acc, brow, bcol, lds, par);
        if (!has_next) break;
#pragma unroll
        for (int a = 0; a < 2; ++a)
#pragma unroll
            for (int b = 0; b < 2; ++b)
#pragma unroll
                for (int m = 0; m < 4; ++m)
#pragma unroll
                    for (int n = 0; n < 2; ++n) acc[a][b][m][n] = (f32x4){0.f, 0.f, 0.f, 0.f};
        brow = nrow; bcol = ncol; cA = nA; cB = nB;
        if (wr == 1) BAR;
    }
    WAIT_V(0);
    BAR;
#undef STG_A
#undef STG_B
#undef LDA
#undef LDB
#undef MMA
}

DEV void skinny_reduce(LAS unsigned char* lds, int wid, int lane, const f32x4 (&acc)[16], f32x4& a0, f32x4& a1) {
#pragma unroll
    for (int nb = 0; nb < 16; ++nb) *(LAS f32x4*)(lds + ((wid * 16 + nb) * 64 + lane) * 16) = acc[nb];
    __syncthreads();
    a0 = (f32x4){0.f, 0.f, 0.f, 0.f}; a1 = a0;
#pragma unroll
    for (int w = 0; w < 8; ++w) { a0 += *(const LAS f32x4*)(lds + ((w * 16 + 2 * wid) * 64 + lane) * 16); a1 += *(const LAS f32x4*)(lds + ((w * 16 + 2 * wid + 1) * 64 + lane) * 16); }
    __syncthreads();
}
template <class Epi>
DEV void skinny_item(LAS unsigned char* lds, const bf16_t* __restrict__ A, int lda, const bf16_t* __restrict__ B, int ldb, int K, int mb, int pn, const Epi& epi) {
    int tid = threadIdx.x; asm volatile("" : "+v"(tid));
    const int wid = tid >> 6, lane = tid & 63, fr = lane & 15, fq = lane >> 4;
    const bf16_t* ap = A + (size_t)(TX + mb * 16 + fr) * lda + fq * 8;
    const bf16_t* bp = B + (size_t)(pn * 256 + fr) * ldb + fq * 8;
    const size_t b16 = (size_t)16 * ldb;
    f32x4 acc[16];
#pragma unroll
    for (int nb = 0; nb < 16; ++nb) acc[nb] = (f32x4){0.f, 0.f, 0.f, 0.f};
    const int nsteps = K >> 5;
#pragma unroll 1
    for (int st = wid; st < nsteps; st += 8) {
        const int k0 = st * 32;
        const bf16x8 a = *(const bf16x8*)(ap + k0);
        bf16x8 b[16];
#pragma unroll
        for (int nb = 0; nb < 16; ++nb) b[nb] = *(const bf16x8*)(bp + nb * b16 + k0);
        SCHED;
#pragma unroll
        for (int nb = 0; nb < 16; ++nb) acc[nb] = __builtin_amdgcn_mfma_f32_16x16x32_bf16(b[nb], a, acc[nb], 0, 0, 0);
        SCHED;
    }
    f32x4 a0, a1;
    skinny_reduce(lds, wid, lane, acc, a0, a1);
    epi.skinny(a0, a1, mb, pn, lds);
}

template <class Epi>
DEV void skinny_dft(LAS unsigned char* lds, const bf16_t* __restrict__ A, int lda, const bf16_t* __restrict__ B, int N, int K, int arow0, int ncol0, const Epi& epi) {
    int tid = threadIdx.x; asm volatile("" : "+v"(tid));
    const int wid = tid >> 6, lane = tid & 63, fr = lane & 15, fq = lane >> 4;
    const bf16_t* ap = A + (size_t)(arow0 + fr) * lda + fq * 8;
    const bf16_t* bp = B + ((size_t)fq * N + ncol0 + fr) * 8;
    const size_t bstep = (size_t)4 * N * 8;
    f32x4 acc[16];
#pragma unroll
    for (int nb = 0; nb < 16; ++nb) acc[nb] = (f32x4){0.f, 0.f, 0.f, 0.f};
    const int nsteps = K >> 5;
#pragma unroll 1
    for (int st = wid; st < nsteps; st += 8) {
        const bf16x8 a = *(const bf16x8*)(ap + st * 32);
        const bf16_t* bq = bp + st * bstep;
        bf16x8 b[16];
#pragma unroll
        for (int nb = 0; nb < 16; ++nb) b[nb] = *(const bf16x8*)(bq + nb * 128);
        SCHED;
#pragma unroll
        for (int nb = 0; nb < 16; ++nb) acc[nb] = __builtin_amdgcn_mfma_f32_16x16x32_bf16(b[nb], a, acc[nb], 0, 0, 0);
        SCHED;
    }
    f32x4 a0, a1;
    skinny_reduce(lds, wid, lane, acc, a0, a1);
    epi.skinny(a0, a1, lds);
}

struct TileMap { int nM, nN; DEV void operator()(int t, int& brow, int& bcol) const; };
struct TileMapRev { int nM, nN; DEV void operator()(int t, int& brow, int& bcol) const; };
struct TileG1 { DEV void operator()(int t, int& brow, int& bcol) const; };
struct TileOne { int brow_, bcol_; DEV void operator()(int, int& brow, int& bcol) const { brow = brow_; bcol = bcol_; } };

DEV void tile_map(int L, int nM, int nN, int& pm, int& pn) {
    const int nwg = nM * nN; int wgid = L;
    { const int q = nwg / 8, r = nwg % 8, xcd = wgid % 8, off = wgid / 8; wgid = (xcd < r ? xcd * (q + 1) : r * (q + 1) + (xcd - r) * q) + off; }
    const int nig = 4 * nN, gid = wgid / nig, fm = gid * 4, gsz = (nM - fm) < 4 ? (nM - fm) : 4;
    pm = fm + ((wgid % nig) % gsz); pn = (wgid % nig) / gsz;
}

DEV void TileMap::operator()(int t, int& brow, int& bcol) const { int pm, pn; tile_map(t, nM, nN, pm, pn); brow = pm * 256; bcol = pn * 256; }
DEV void TileG1::operator()(int t, int& brow, int& bcol) const { int pm, pn; tile_map(t, 192, 7, pm, pn); brow = pm * 256; bcol = (pn == 0 ? 6 : pn - 1) * 256; }
DEV void TileMapRev::operator()(int t, int& brow, int& bcol) const { int pm, pn; tile_map(t, nM, nN, pm, pn); brow = (nM - 1 - pm) * 256; bcol = pn * 256; }

#define EPI_IDS int tid = threadIdx.x; asm volatile("" : "+v"(tid)); const int wid = tid >> 6, lane = tid & 63, wr = wid >> 2, wc = wid & 3, fr = lane & 15, fq = lane >> 4; (void)wc; (void)fq; (void)fr; (void)wr;

DEV float row_rs(const float* ss, int row) { const f32x4 s4 = *(const f32x4*)(ss + (size_t)row * 4); return rsqrtf(((s4[0] + s4[1]) + (s4[2] + s4[3])) * (1.0f / 1024.0f) + EPS); }

struct Epi1 {
    static constexpr bool PERM = true;
    bf16_t* z; const float* ss; unsigned* vcnt;
    DEV void prefetch(LAS unsigned char* lds, int brow, int par, int tid) const { if (tid < 256) GLDS(ss + (size_t)(brow + tid) * 4, lds + LDS_EX + par * 4096 + tid * 16); }
    DEV void publish(int tid) const {
        asm volatile("s_waitcnt vmcnt(0)" ::: "memory");
        __syncthreads();
        if (tid == 0) (void)__hip_atomic_fetch_add(vcnt, 1u, __ATOMIC_RELAXED, __HIP_MEMORY_SCOPE_AGENT);
    }
    DEV void publish_fenced(int tid) const {
        asm volatile("s_waitcnt vmcnt(0)" ::: "memory");
        __syncthreads();
        if (tid == 0) { __builtin_amdgcn_fence(__ATOMIC_RELEASE, "agent"); asm volatile("s_waitcnt vmcnt(0)" ::: "memory"); (void)__hip_atomic_fetch_add(vcnt, 1u, __ATOMIC_RELAXED, __HIP_MEMORY_SCOPE_AGENT); }
    }
    DEV void operator()(f32x4 (&acc)[2][2][4][2], int brow, int bcol, LAS unsigned char* lds, int par) const {
        EPI_IDS
        const rsrc_t zr = make_rsrc(z, (unsigned)((size_t)TP * NZ * 2));
        const bool vt = bcol == 6 * 256;
#pragma unroll
        for (int ai = 0; ai < 2; ++ai)
#pragma unroll
            for (int m = 0; m < 4; ++m) {
                const int lr = ai * 128 + wr * 64 + m * 16 + fr, row = brow + lr;
                const f32x4 s4 = *(const LAS f32x4*)(lds + LDS_EX + par * 4096 + lr * 16);
                const float rs = rsqrtf(((s4[0] + s4[1]) + (s4[2] + s4[3])) * (1.0f / 1024.0f) + EPS);
#pragma unroll
                for (int bj = 0; bj < 2; ++bj) {
                    const f32x4 v0 = acc[ai][bj][m][0] * rs, v1 = acc[ai][bj][m][1] * rs;
                    u32x4 w; w.x = cvt_pk_bf16(v0[0], v0[1]); w.y = cvt_pk_bf16(v0[2], v0[3]); w.z = cvt_pk_bf16(v1[0], v1[1]); w.w = cvt_pk_bf16(v1[2], v1[3]);
                    if (vt) st16_wt(zr, (unsigned)(row * NZ + bcol + bj * 128 + wc * 32 + fq * 8) * 2u, w);
                    else *(u32x4*)(z + (size_t)row * NZ + bcol + bj * 128 + wc * 32 + fq * 8) = w;
                }
            }
        if (vt) publish(tid);
    }
    DEV void skinny(f32x4 a0, f32x4 a1, int mb, int pn, LAS unsigned char*) const {
        EPI_IDS
        const int row = TX + mb * 16 + fr;
        const float rs = row_rs(ss, row);
        const f32x4 v0 = a0 * rs, v1 = a1 * rs;
        bf16_t* zp = z + (size_t)row * NZ + pn * 256 + wid * 32 + fq * 4;
        *(u32x2*)zp = (u32x2){cvt_pk_bf16(v0[0], v0[1]), cvt_pk_bf16(v0[2], v0[3])};
        *(u32x2*)(zp + 16) = (u32x2){cvt_pk_bf16(v1[0], v1[1]), cvt_pk_bf16(v1[2], v1[3])};
        if (pn == 6) publish_fenced(tid);
    }
};

struct EpiRes {
    static constexpr bool PERM = true;
    bf16_t* hb; float* ssout;
    DEV void prefetch(LAS unsigned char*, int, int, int) const {}
    DEV void operator()(f32x4 (&acc)[2][2][4][2], int brow, int bcol, LAS unsigned char* lds, int) const {
        EPI_IDS
        LAS float* ex = (LAS float*)(lds + LDS_EX);
        bf16_t* hp0 = hb + (size_t)(brow + wr * 64 + fr) * D + bcol + wc * 32 + fq * 8;
        u32x4 res[2][4][2];
#pragma unroll
        for (int ai = 0; ai < 2; ++ai)
#pragma unroll
            for (int m = 0; m < 4; ++m)
#pragma unroll
                for (int bj = 0; bj < 2; ++bj) res[ai][m][bj] = *(const u32x4*)(hp0 + (size_t)(ai * 128 + m * 16) * D + bj * 128);
        SCHED;
#pragma unroll
        for (int ai = 0; ai < 2; ++ai)
#pragma unroll
            for (int m = 0; m < 4; ++m) {
                const int lr = ai * 128 + wr * 64 + m * 16 + fr;
                float s = 0.f;
#pragma unroll
                for (int bj = 0; bj < 2; ++bj) {
                    const u32x4 r = res[ai][m][bj];
                    f32x4 v0 = acc[ai][bj][m][0], v1 = acc[ai][bj][m][1];
                    v0[0] += bflo(r.x); v0[1] += bfhi(r.x); v0[2] += bflo(r.y); v0[3] += bfhi(r.y);
                    v1[0] += bflo(r.z); v1[1] += bfhi(r.z); v1[2] += bflo(r.w); v1[3] += bfhi(r.w);
                    u32x4 w; w.x = cvt_pk_bf16(v0[0], v0[1]); w.y = cvt_pk_bf16(v0[2], v0[3]); w.z = cvt_pk_bf16(v1[0], v1[1]); w.w = cvt_pk_bf16(v1[2], v1[3]);
                    *(u32x4*)(hp0 + (size_t)(ai * 128 + m * 16) * D + bj * 128) = w;
                    s += ((v0[0] * v0[0] + v0[1] * v0[1]) + (v0[2] * v0[2] + v0[3] * v0[3])) + ((v1[0] * v1[0] + v1[1] * v1[1]) + (v1[2] * v1[2] + v1[3] * v1[3]));
                }
                s += __shfl_xor(s, 16); s += __shfl_xor(s, 32);
                if (fq == 0) ex[lr * 4 + wc] = s;
            }
        __syncthreads();
        if (tid < 256) { const f32x4 e = *(const LAS f32x4*)(ex + tid * 4); ssout[(size_t)(brow + tid) * 4 + (bcol >> 8)] = (e[0] + e[1]) + (e[2] + e[3]); }
    }
    DEV void skinny(f32x4 a0, f32x4 a1, int mb, int pn, LAS unsigned char* lds) const {
        EPI_IDS
        const int row = TX + mb * 16 + fr, col = pn * 256 + wid * 32 + fq * 4;
        bf16_t* bp = hb + (size_t)row * D + col;
        const u32x2 r0 = *(const u32x2*)bp, r1 = *(const u32x2*)(bp + 16);
        f32x4 v0 = a0, v1 = a1;
        v0[0] += bflo(r0.x); v0[1] += bfhi(r0.x); v0[2] += bflo(r0.y); v0[3] += bfhi(r0.y);
        v1[0] += bflo(r1.x); v1[1] += bfhi(r1.x); v1[2] += bflo(r1.y); v1[3] += bfhi(r1.y);
        *(u32x2*)bp = (u32x2){cvt_pk_bf16(v0[0], v0[1]), cvt_pk_bf16(v0[2], v0[3])};
        *(u32x2*)(bp + 16) = (u32x2){cvt_pk_bf16(v1[0], v1[1]), cvt_pk_bf16(v1[2], v1[3])};
        float s = ((v0[0] * v0[0] + v0[1] * v0[1]) + (v0[2] * v0[2] + v0[3] * v0[3])) + ((v1[0] * v1[0] + v1[1] * v1[1]) + (v1[2] * v1[2] + v1[3] * v1[3]));
        s += __shfl_xor(s, 16); s += __shfl_xor(s, 32);
        LAS float* ex = (LAS float*)(lds + LDS_EX);
        if (fq == 0) ex[fr * 8 + wid] = s;
        __syncthreads();
        if (tid < 16) { const f32x4 e0 = *(const LAS f32x4*)(ex + tid * 8), e1 = *(const LAS f32x4*)(ex + tid * 8 + 4);
            ssout[(size_t)(TX + mb * 16 + tid) * 4 + pn] = ((e0[0] + e0[1]) + (e0[2] + e0[3])) + ((e1[0] + e1[1]) + (e1[2] + e1[3])); }
        __syncthreads();
    }
};

struct Epi3 {
    static constexpr bool PERM = false;
    bf16_t* act; const float* ss; unsigned* mcnt;
    DEV void prefetch(LAS unsigned char* lds, int brow, int par, int tid) const { if (tid < 256) GLDS(ss + (size_t)(brow + tid) * 4, lds + LDS_EX + par * 4096 + tid * 16); }
    DEV void operator()(f32x4 (&acc)[2][2][4][2], int brow, int bcol, LAS unsigned char* lds, int par) const {
        EPI_IDS
#pragma unroll
        for (int ai = 0; ai < 2; ++ai)
#pragma unroll
            for (int m = 0; m < 4; ++m) {
                const int lr = ai * 128 + wr * 64 + m * 16 + fr, row = brow + lr;
                const f32x4 s4 = *(const LAS f32x4*)(lds + LDS_EX + par * 4096 + lr * 16);
                const float rs = rsqrtf(((s4[0] + s4[1]) + (s4[2] + s4[3])) * (1.0f / 1024.0f) + EPS);
                float o[8];
                const float rs2 = rs * rs, ce = rs * -1.4426950408889634f;
#pragma unroll
                for (int bj = 0; bj < 2; ++bj) {
                    const f32x4 g = acc[ai][bj][m][0], u = acc[ai][bj][m][1];
#pragma unroll
                    for (int j = 0; j < 4; ++j) o[bj * 4 + j] = (g[j] * u[j]) * rs2 * __builtin_amdgcn_rcpf(1.0f + __builtin_amdgcn_exp2f(g[j] * ce));
                }
                *(u32x4*)(act + (size_t)row * DFF + (bcol >> 1) + wc * 32 + fq * 8) = pack8(o);
            }
    }
    DEV void skinny(f32x4 a0, f32x4 a1, int mb, int pn, LAS unsigned char*) const {
        EPI_IDS
        const int row = TX + mb * 16 + fr;
        const float rs = row_rs(ss, row);
        const f32x4 g = a0 * rs, u = a1 * rs;
        float o[4];
#pragma unroll
        for (int j = 0; j < 4; ++j) o[j] = g[j] * __builtin_amdgcn_rcpf(1.0f + __expf(-g[j])) * u[j];
        *(u32x2*)(act + (size_t)row * DFF + pn * 128 + (wid & 3) * 32 + fq * 8 + (wid >> 2) * 4) = (u32x2){cvt_pk_bf16(o[0], o[1]), cvt_pk_bf16(o[2], o[3])};
        asm volatile("s_waitcnt vmcnt(0)" ::: "memory");
        __syncthreads();
        if (tid == 0) { __builtin_amdgcn_fence(__ATOMIC_RELEASE, "agent"); asm volatile("s_waitcnt vmcnt(0)" ::: "memory"); (void)__hip_atomic_fetch_add(mcnt, 1u, __ATOMIC_RELAXED, __HIP_MEMORY_SCOPE_AGENT); }
    }
};

struct EpiF {
    static constexpr bool PERM = true;
    bf16_t* mix; int s, k1, L2;
    DEV void prefetch(LAS unsigned char*, int, int, int) const {}
    DEV void operator()(f32x4 (&acc)[2][2][4][2], int brow, int bcol, LAS unsigned char* lds, int) const {
        EPI_IDS
        LAS float* ex = (LAS float*)(lds + LDS_EX);
#pragma unroll
        for (int ai = 0; ai < 2; ++ai)
#pragma unroll
            for (int m = 0; m < 4; ++m) {
                const int lr = ai * 128 + wr * 64 + m * 16 + fr;
                float q = 0.f;
#pragma unroll
                for (int bj = 0; bj < 2; ++bj)
#pragma unroll
                    for (int n = 0; n < 2; ++n) { const f32x4 v = acc[ai][bj][m][n]; q += (v[0] * v[0] + v[1] * v[1]) + (v[2] * v[2] + v[3] * v[3]); }
                q += __shfl_xor(q, 16); q += __shfl_xor(q, 32);
                if (fq == 0) ex[lr * 4 + wc] = q;
            }
        __syncthreads();
#pragma unroll
        for (int ai = 0; ai < 2; ++ai)
#pragma unroll
            for (int m = 0; m < 4; ++m) {
                const int lr = ai * 128 + wr * 64 + m * 16 + fr, k2 = brow + lr;
                const f32x4 e = *(const LAS f32x4*)(ex + lr * 4);
                const float rs = rsqrtf(((e[0] + e[1]) + (e[2] + e[3])) * (1.0f / 256.0f) + EPS);
                if (k2 < L2) {
                    const int row = rowof(s, k1 + 16 * k2);
#pragma unroll
                    for (int bj = 0; bj < 2; ++bj) {
                        const f32x4 v0 = acc[ai][bj][m][0] * rs, v1 = acc[ai][bj][m][1] * rs;
                        u32x4 w; w.x = cvt_pk_bf16(v0[0], v0[1]); w.y = cvt_pk_bf16(v0[2], v0[3]); w.z = cvt_pk_bf16(v1[0], v1[1]); w.w = cvt_pk_bf16(v1[2], v1[3]);
                        *(u32x4*)(mix + (size_t)row * D + 768 + bj * 128 + wc * 32 + fq * 8) = w;
                    }
                }
            }
    }
    DEV void skinny(f32x4 a0, f32x4 a1, LAS unsigned char* lds) const {
        EPI_IDS
        float q = ((a0[0] * a0[0] + a0[1] * a0[1]) + (a0[2] * a0[2] + a0[3] * a0[3])) + ((a1[0] * a1[0] + a1[1] * a1[1]) + (a1[2] * a1[2] + a1[3] * a1[3]));
        q += __shfl_xor(q, 16); q += __shfl_xor(q, 32);
        LAS float* ex = (LAS float*)(lds + LDS_EX);
        if (fq == 0) ex[fr * 8 + wid] = q;
        __syncthreads();
        if (fr == 0) {
            const f32x4 e0 = *(const LAS f32x4*)ex, e1 = *(const LAS f32x4*)(ex + 4);
            const float rs = rsqrtf((((e0[0] + e0[1]) + (e0[2] + e0[3])) + ((e1[0] + e1[1]) + (e1[2] + e1[3]))) * (1.0f / 256.0f) + EPS);
            bf16_t* mp = mix + (size_t)rowof(s, k1 + 16 * (L2 - 1)) * D + 768 + wid * 32 + fq * 4;
            const f32x4 v0 = a0 * rs, v1 = a1 * rs;
            *(u32x2*)mp = (u32x2){cvt_pk_bf16(v0[0], v0[1]), cvt_pk_bf16(v0[2], v0[3])};
            *(u32x2*)(mp + 16) = (u32x2){cvt_pk_bf16(v1[0], v1[1]), cvt_pk_bf16(v1[2], v1[3])};
        }
        __syncthreads();
    }
};


DEV void phase_prologue(const Params& p, LAS unsigned char* lds) {
    unsigned char* ws = p.ws;
    int tid = threadIdx.x; asm volatile("" : "+v"(tid));
    const long gt = (long)blockIdx.x * NT + tid, gs = (long)gridDim.x * NT;
    LAS float* ctab = (LAS float*)lds;
    if (tid < 64) ctab[tid] = cospif((float)tid * (1.0f / 32.0f));
    __syncthreads();
    bf16_t* W1 = (bf16_t*)(ws + WS_W1); bf16_t* W2 = (bf16_t*)(ws + WS_W2); bf16_t* W3 = (bf16_t*)(ws + WS_W3); bf16_t* W4 = (bf16_t*)(ws + WS_W4);
    LAS unsigned char* xl = lds + 1024;
#define XPOSE_STORE4(pieces, dst0, ldk) do { _Pragma("unroll") for (int _q = 0; _q < 4; ++_q) *(LAS u32x4*)(xl + _q * 9216 + ((tid & 63) * 9 + (tid >> 6)) * 16) = (pieces)[_q]; __syncthreads(); \
        const int _r = tid >> 3, _c = tid & 7; _Pragma("unroll") for (int _q = 0; _q < 4; ++_q) { const u32x4 _v = *(const LAS u32x4*)(xl + _q * 9216 + (_r * 9 + _c) * 16); \
        *(u32x4*)((dst0) + (size_t)(_q * 64 + _r) * (ldk) + _c * 8) = _v; } __syncthreads(); } while (0)
    const int nl = tid & 63, k8l = tid >> 6;
    for (int S = blockIdx.x; S < DEPTH * 16 * 6; S += gridDim.x) {
        const int nq = S % 6, kb = (S / 6) % 16, l = S / (6 * 16), k0 = kb * 64 + k8l * 8;
        float v[4][8];
#pragma unroll
        for (int j = 0; j < 8; ++j) { const int k = k0 + j; const float g = p.norm1_g[l * D + k]; const float* src = p.w_in + ((size_t)l * D + k) * NIN0 + nq * 256 + nl;
#pragma unroll
            for (int q = 0; q < 4; ++q) v[q][j] = src[q * 64] * g; }
        u32x4 pc[4];
#pragma unroll
        for (int q = 0; q < 4; ++q) pc[q] = pack8(v[q]);
        XPOSE_STORE4(pc, W1 + ((size_t)l * NZ + nq * 256) * D + kb * 64, D);
    }
    for (int S = blockIdx.x; S < DEPTH * 16 * 4; S += gridDim.x) {
        const int nq = S % 4, kb = (S / 4) % 16, l = S / (4 * 16), k0 = kb * 64 + k8l * 8;
        float v[4][8];
#pragma unroll
        for (int j = 0; j < 8; ++j) { const int k = k0 + j; const float g = p.mix_g[l * D + k]; const float* src = p.w_out + ((size_t)l * D + k) * D + nq * 256 + nl;
#pragma unroll
            for (int q = 0; q < 4; ++q) v[q][j] = src[q * 64] * g; }
        u32x4 pc[4];
#pragma unroll
        for (int q = 0; q < 4; ++q) pc[q] = pack8(v[q]);
        XPOSE_STORE4(pc, W2 + ((size_t)l * D + nq * 256) * D + kb * 64, D);
    }
    for (int S = blockIdx.x; S < DEPTH * 16 * 22; S += gridDim.x) {
        const int pn = S % 22, kb = (S / 22) % 16, l = S / (22 * 16), k0 = kb * 64 + k8l * 8;
        int col[4];
#pragma unroll
        for (int q = 0; q < 4; ++q) { const int rem = q * 64 + nl, bj = rem >> 7, wc = (rem >> 5) & 3, nn = (rem >> 4) & 1, i = rem & 15;
            const int d = pn * 128 + wc * 32 + (i >> 2) * 8 + bj * 4 + (i & 3); col[q] = nn ? DFF + d : d; }
        float v[4][8];
#pragma unroll
        for (int j = 0; j < 8; ++j) { const int k = k0 + j; const float g = p.norm2_g[l * D + k]; const float* src = p.w_gate_up + ((size_t)l * D + k) * NGU;
#pragma unroll
            for (int q = 0; q < 4; ++q) v[q][j] = src[col[q]] * g; }
        u32x4 pc[4];
#pragma unroll
        for (int q = 0; q < 4; ++q) pc[q] = pack8(v[q]);
        XPOSE_STORE4(pc, W3 + ((size_t)l * NGU + pn * 256) * D + kb * 64, D);
    }
    for (int S = blockIdx.x; S < DEPTH * 44 * 4; S += gridDim.x) {
        const int nq = S % 4, kb = (S / 4) % 44, l = S / (4 * 44), k0 = kb * 64 + k8l * 8;
        float v[4][8];
#pragma unroll
        for (int j = 0; j < 8; ++j) { const int k = k0 + j; const float* src = p.w_down + ((size_t)l * DFF + k) * D + nq * 256 + nl;
#pragma unroll
            for (int q = 0; q < 4; ++q) v[q][j] = src[q * 64]; }
        u32x4 pc[4];
#pragma unroll
        for (int q = 0; q < 4; ++q) pc[q] = pack8(v[q]);
        XPOSE_STORE4(pc, W4 + ((size_t)l * D + nq * 256) * DFF + kb * 64, DFF);
    }
#undef XPOSE_STORE4
    {
        float tt[64];
#pragma unroll
        for (int c = 0; c < 64; ++c) { const int jj = ((nl < 33 ? nl : nl - 32) * c) & 63; tt[c] = nl < 33 ? ctab[jj] : -ctab[(jj - 16) & 63]; }
        LAS float* sb = (LAS float*)(lds + 40960);
        for (int S = blockIdx.x; S < DEPTH * 16 * 4; S += gridDim.x) {
            const int hd = S % 4, kb = (S / 4) % 16, l = S / (4 * 16);
#pragma unroll
            for (int j = 0; j < 2; ++j) { const int k = (tid >> 4) + 32 * j, c4 = (tid & 15) * 4;
                *(LAS f32x4*)(sb + k * 64 + c4) = *(const f32x4*)(p.w_in + ((size_t)l * D + kb * 64 + k) * NIN0 + 1536 + hd * 64 + c4); }
            __syncthreads();
            float val[8];
#pragma unroll
            for (int j = 0; j < 8; ++j) {
                const int k = k8l * 8 + j;
                float a = 0.f;
#pragma unroll
                for (int c4 = 0; c4 < 64; c4 += 4) { const f32x4 x = *(const LAS f32x4*)(sb + k * 64 + c4);
#pragma unroll
                    for (int e = 0; e < 4; ++e) a += x[e] * tt[c4 + e]; }
                val[j] = a * p.norm1_g[l * D + kb * 64 + k];
            }
            *(LAS u32x4*)(xl + ((tid & 63) * 9 + (tid >> 6)) * 16) = pack8(val);
            __syncthreads();
            { const int r = tid >> 3, c = tid & 7;
              *(u32x4*)(W1 + ((size_t)l * NZ + 1536 + hd * 64 + r) * D + kb * 64 + c * 8) = *(const LAS u32x4*)(xl + (r * 9 + c) * 16); }
            __syncthreads();
        }
    }
    bf16_t* PW = (bf16_t*)(ws + WS_PW);
    for (long i = gt; i < (long)DEPTH * 4 * 96 * 96; i += gs) {
        const int k = (int)(i % 96), n = (int)((i / 96) % 96), lg = (int)(i / (96 * 96)), l = lg >> 2, g = lg & 3;
        const float v = p.pool_w[((size_t)lg * 96 + k) * 96 + n] * p.pool_scale[l * 384 + g * 96 + n];
        PW[i] = (bf16_t)(cvt_pk_bf16(v, 0.f) & 0xffff);
    }
    bf16_t* DPm = (bf16_t*)(ws + WS_DP); bf16_t* DSm = (bf16_t*)(ws + WS_DS);
    for (long i = gt; i < (long)MPP * KP; i += gs) {
        const int kk = (int)(i % KP), k2 = (int)(i / KP), part = kk / KHP, n2 = kk % KHP;
        float v = 0.f;
        if (k2 < L2P && n2 < L2P) { const float a = (float)(2 * ((k2 * n2) % L2P)) * (1.0f / (float)L2P); v = part == 0 ? cospif(a) : sinpif(a); }
        DPm[i] = (bf16_t)(cvt_pk_bf16(v, 0.f) & 0xffff);
    }
    for (long i = gt; i < (long)MPS * KS; i += gs) {
        const int kk = (int)(i % KS), k2 = (int)(i / KS), part = kk / KHS, n2 = kk % KHS;
        float v = 0.f;
        if (k2 < L2S && n2 < L2S) { const float a = (float)(2 * ((k2 * n2) % L2S)) * (1.0f / (float)L2S); v = part == 0 ? cospif(a) : sinpif(a); }
        DSm[i] = (bf16_t)(cvt_pk_bf16(v, 0.f) & 0xffff);
    }
    f32x2* TWPt = (f32x2*)(ws + WS_TWP); f32x2* TWSt = (f32x2*)(ws + WS_TWS);
    for (long i = gt; i < 16 * KHP; i += gs) {
        const int n2 = (int)(i % KHP), k1 = (int)(i / KHP);
        const float a = (float)(2 * ((k1 * n2) % LP)) * (1.0f / (float)LP), sc = 1.0f / sqrtf(64.0f * (float)LP);
        TWPt[i] = (f32x2){cospif(a) * sc, -sinpif(a) * sc};
    }
    for (long i = gt; i < 16 * KHS; i += gs) {
        const int n2 = (int)(i % KHS), k1 = (int)(i / KHS);
        const float a = (float)(2 * ((k1 * n2) % LS)) * (1.0f / (float)LS), sc = 1.0f / sqrtf(64.0f * (float)LS);
        TWSt[i] = (f32x2){cospif(a) * sc, -sinpif(a) * sc};
    }
    bf16_t* hb = (bf16_t*)(ws + WS_HB); float* ss1 = (float*)(ws + WS_SS1);
    const int lane = tid & 63, gw = (int)(gt >> 6), nw = (int)(gs >> 6);
    for (int r0 = gw * 4; r0 < T; r0 += nw * 4) {
        f32x4 v[4][4];
#pragma unroll
        for (int q = 0; q < 4; ++q) {
            const int r = r0 + q;
            const float* src = r < 16384 ? p.x_prompt + (size_t)r * D : (r < TX ? p.x_sample + (size_t)(r - 16384) * D : p.meta + (size_t)((r - TX) & 15) * D);
#pragma unroll
            for (int j = 0; j < 4; ++j) v[q][j] = *(const f32x4*)(src + j * 256 + lane * 4);
        }
        float s[4];
#pragma unroll
        for (int q = 0; q < 4; ++q) {
            s[q] = 0.f;
#pragma unroll
            for (int j = 0; j < 4; ++j) {
                const f32x4 x = v[q][j];
                u32x2 w; w.x = cvt_pk_bf16(x[0], x[1]); w.y = cvt_pk_bf16(x[2], x[3]);
                *(u32x2*)(hb + (size_t)(r0 + q) * D + j * 256 + lane * 4) = w;
                s[q] += (x[0] * x[0] + x[1] * x[1]) + (x[2] * x[2] + x[3] * x[3]);
            }
        }
#pragma unroll
        for (int o = 32; o >= 1; o >>= 1)
#pragma unroll
            for (int q = 0; q < 4; ++q) s[q] += __shfl_xor(s[q], o);
        if (lane < 4) { const float sv = lane == 0 ? s[0] : (lane == 1 ? s[1] : (lane == 2 ? s[2] : s[3])); *(f32x4*)(ss1 + (size_t)(r0 + lane) * 4) = (f32x4){sv, 0.f, 0.f, 0.f}; }
    }
}

DEV void phase_xb(const Params& p, int it0, int itstep);
DEV void phase_gemm1(const Params& p, int l, LAS unsigned char* lds) {
    unsigned char* ws = p.ws;
    unsigned* vcnt = (unsigned*)(ws + WS_BAR) + VCNT_WORD0 + 64 * l;
    Epi1 e{(bf16_t*)(ws + WS_Z), (const float*)(ws + WS_SS1), vcnt};
    const bf16_t* A = (const bf16_t*)(ws + WS_HB); const bf16_t* B = (const bf16_t*)(ws + WS_W1) + (size_t)l * NZ * D;
    const int G = gridDim.x, b = blockIdx.x;
    const bool tail = (G == 256) ? (b >= 64) : true;
    if (G == 256) { if (b < 63) skinny_item(lds, A, D, B, D, D, b % 9, 6 - b / 9, e); }
    else for (int i = b; i < 9 * 7; i += G) skinny_item(lds, A, D, B, D, D, i % 9, 6 - i / 9, e);
    gemm_loop<0>(lds, A, D, B, D, D, e, b, G, 192 * 7, TileG1{});
    if (tail) {
        int tid = threadIdx.x; asm volatile("" : "+v"(tid));
        if (tid == 0) { unsigned sp = 0; while (__hip_atomic_load(vcnt, __ATOMIC_RELAXED, __HIP_MEMORY_SCOPE_AGENT) < (unsigned)NVTILES) { __builtin_amdgcn_s_sleep(1); if (++sp > (1u << 22)) break; } }
        __syncthreads();
        __builtin_amdgcn_fence(__ATOMIC_ACQUIRE, "agent");
        asm volatile("s_waitcnt vmcnt(0)" ::: "memory");
        if (G == 256) phase_xb(p, b - 64, 192); else phase_xb(p, b, G);
    }
}
DEV void phase_gemm2(const Params& p, int l, LAS unsigned char* lds) {
    unsigned char* ws = p.ws;
    EpiRes e{(bf16_t*)(ws + WS_HB), (float*)(ws + WS_SS2)};
    const bf16_t* A = (const bf16_t*)(ws + WS_MIX); const bf16_t* B = (const bf16_t*)(ws + WS_W2) + (size_t)l * D * D;
    if (l < DEPTH - 1) for (int i = blockIdx.x; i < 9 * 4; i += gridDim.x) skinny_item(lds, A, D, B, D, D, i % 9, i / 9, e);
    gemm_loop<0>(lds, A, D, B, D, D, e, blockIdx.x, gridDim.x, 192 * 4, TileMap{192, 4});
}
DEV void phase_gemm3(const Params& p, int l, LAS unsigned char* lds) {
    unsigned char* ws = p.ws;
    unsigned* mcnt = (unsigned*)(ws + WS_BAR) + MCNT_WORD0 + 64 * l;
    Epi3 e{(bf16_t*)(ws + WS_ACT), (const float*)(ws + WS_SS2), mcnt};
    const bf16_t* A = (const bf16_t*)(ws + WS_HB); const bf16_t* B = (const bf16_t*)(ws + WS_W3) + (size_t)l * NGU * D;
    const int G = gridDim.x, b = blockIdx.x;
    if (l == DEPTH - 1) {}
    else if (G == 256) { if (b >= 128) for (int i = b - 128; i < 9 * 22; i += 128) skinny_item(lds, A, D, B, D, D, i % 9, i / 9, e); }
    else for (int i = b; i < 9 * 22; i += G) skinny_item(lds, A, D, B, D, D, i % 9, i / 9, e);
    gemm_loop<0>(lds, A, D, B, D, D, e, b, G, 192 * 22, TileMap{192, 22});
    if (l < DEPTH - 1 && G == 256 && b >= 220) {
        int tid = threadIdx.x; asm volatile("" : "+v"(tid));
        if (tid == 0) { unsigned sp = 0; while (__hip_atomic_load(mcnt, __ATOMIC_RELAXED, __HIP_MEMORY_SCOPE_AGENT) < 198u) { __builtin_amdgcn_s_sleep(1); if (++sp > (1u << 22)) break; } }
        __syncthreads();
        __builtin_amdgcn_fence(__ATOMIC_ACQUIRE, "agent");
        asm volatile("s_waitcnt vmcnt(0)" ::: "memory");
        EpiRes e4{(bf16_t*)(ws + WS_HB), (float*)(ws + WS_SS1)};
        const int i = b - 220;
        skinny_item(lds, (const bf16_t*)(ws + WS_ACT), DFF, (const bf16_t*)(ws + WS_W4) + (size_t)l * D * DFF, DFF, DFF, i % 9, i / 9, e4);
    }
}
DEV void phase_gemm4(const Params& p, int l, LAS unsigned char* lds) {
    unsigned char* ws = p.ws;
    EpiRes e{(bf16_t*)(ws + WS_HB), (float*)(ws + WS_SS1)};
    const bf16_t* A = (const bf16_t*)(ws + WS_ACT); const bf16_t* B = (const bf16_t*)(ws + WS_W4) + (size_t)l * D * DFF;
    if (l < DEPTH - 1 && gridDim.x != 256) for (int i = blockIdx.x; i < 9 * 4; i += gridDim.x) skinny_item(lds, A, DFF, B, DFF, DFF, i % 9, i / 9, e);
    gemm_loop<0>(lds, A, DFF, B, DFF, DFF, e, blockIdx.x, gridDim.x, 192 * 4, TileMapRev{192, 4});
}
DEV void dft_item(const Params& p, int it, LAS unsigned char* lds) {
    unsigned char* ws = p.ws;
    bf16_t* mix = (bf16_t*)(ws + WS_MIX);
    const bf16_t* wbp = (const bf16_t*)((unsigned char*)p.out + OUT_WBP); const bf16_t* wbs = (const bf16_t*)((unsigned char*)p.out + OUT_WBS);
    if (it < 64) {
        const int pm = it & 3, pn = it >> 2;
        EpiF e{mix, 0, pn, L2P};
        gemm_loop<1>(lds, (const bf16_t*)(ws + WS_DP), KP, wbp, NCP, KP, e, 0, 1, 1, TileOne{pm * 256, pn * 256});
    } else if (it < 192) {
        const int pn = it - 64;
        EpiF e{mix, 1 + (pn >> 4), pn & 15, L2S};
        gemm_loop<1>(lds, (const bf16_t*)(ws + WS_DS), KS, wbs, NCS, KS, e, 0, 1, 1, TileOne{0, pn * 256});
    } else if (it < 208) {
        const int pn = it - 192;
        EpiF e{mix, 0, pn, L2P};
        skinny_dft(lds, (const bf16_t*)(ws + WS_DP), KP, wbp, NCP, KP, L2P - 1, pn * 256, e);
    } else {
        const int pn = it - 208;
        EpiF e{mix, 1 + (pn >> 4), pn & 15, L2S};
        skinny_dft(lds, (const bf16_t*)(ws + WS_DS), KS, wbs, NCS, KS, L2S - 1, pn * 256, e);
    }
}
DEV void phase_dft(const Params& p, LAS unsigned char* lds) {
    const int b = blockIdx.x, G = gridDim.x;
    if (G == 256) {
        if (b < 192) dft_item(p, b, lds);
        else for (int it = b; it < 336; it += 64) dft_item(p, it, lds);
    } else {
        for (int it = b; it < 336; it += G) dft_item(p, it, lds);
    }
}

struct XaTile { int s, p0, np, L; };
DEV XaTile xa_next(int& g0, int g1) {
    XaTile t; t.s = 0; t.p0 = 0; t.np = 0; t.L = 16;
    if (g0 < g1) {
        int gs, gl;
        if (g0 < 1025) { t.s = 0; gs = 0; gl = 1025; } else { const int q = (g0 - 1025) / 257; t.s = 1 + q; gs = 1025 + 257 * q; gl = 257; }
        const int ng = min(4, min(g1, gs + gl) - g0);
        t.p0 = (g0 - gs) * 16; t.np = ng * 16; t.L = gl * 16; g0 += ng;
    }
    return t;
}
DEV void xa_stage_load(const bf16_t* z, const XaTile& t, int tid, u32x4 (&v)[8]) {
    const int nchunk = (t.np + 15) * 48;
#pragma unroll
    for (int j = 0; j < 8; ++j) {
        const int c = tid + j * NT, i = c / 48, cg8 = c % 48, pp = t.p0 - 8 + i;
        v[j] = (u32x4){0u, 0u, 0u, 0u};
        if (t.np > 0 && c < nchunk && pp >= 0 && pp < t.L) v[j] = *(const u32x4*)(z + (size_t)rowof(t.s, pp) * NZ + 1152 + cg8 * 8);
    }
}
struct ConvRegs { u32x4 xa[6], gc[6], gb[4]; };
DEV void xa_conv_load(const bf16_t* z, const XaTile& t, int tb, int lane, ConvRegs& r, int (&rows)[6]) {
#pragma unroll
    for (int i = 0; i < 6; ++i) { const int pp = t.p0 + tb - 1 + i; rows[i] = rowof(t.s, min(max(pp, 0), t.L - 1)); }
    if (tb < t.np && lane < 48) {
        const int c = lane * 8;
#pragma unroll
        for (int i = 0; i < 6; ++i) { const bf16_t* q = z + (size_t)rows[i] * NZ + c; r.xa[i] = *(const u32x4*)q; r.gc[i] = *(const u32x4*)(q + 768); }
#pragma unroll
        for (int k = 0; k < 4; ++k) r.gb[k] = *(const u32x4*)(z + (size_t)rows[k + 1] * NZ + c + 384);
    }
}
DEV void xa_conv_finish(bf16_t* mix, const float* cw, const XaTile& t, int tb, int lane, const ConvRegs& r, const int (&rows)[6]) {
    if (tb >= t.np) return;
    float a[4][8]; float sq[4] = {0.f, 0.f, 0.f, 0.f};
    if (lane < 48) {
        const int c = lane * 8;
        float wv[3][8];
#pragma unroll
        for (int q = 0; q < 3; ++q) { const f32x4 w0 = *(const f32x4*)(cw + q * 384 + c), w1 = *(const f32x4*)(cw + q * 384 + c + 4);
#pragma unroll
            for (int j = 0; j < 4; ++j) { wv[q][j] = w0[j]; wv[q][4 + j] = w1[j]; } }
        float y[6][8];
#pragma unroll
        for (int i = 0; i < 6; ++i) {
            const int pp = t.p0 + tb - 1 + i;
            const float msk = (pp >= 0 && pp < t.L) ? 1.0f : 0.0f;
#pragma unroll
            for (int j = 0; j < 4; ++j) { y[i][2 * j] = bflo(r.xa[i][j]) * bflo(r.gc[i][j]) * msk; y[i][2 * j + 1] = bfhi(r.xa[i][j]) * bfhi(r.gc[i][j]) * msk; }
        }
#pragma unroll
        for (int k = 0; k < 4; ++k)
#pragma unroll
            for (int j = 0; j < 4; ++j) {
                const int e0 = 2 * j, e1 = 2 * j + 1;
                a[k][e0] = bflo(r.gb[k][j]) * (wv[0][e0] * y[k][e0] + wv[1][e0] * y[k + 1][e0] + wv[2][e0] * y[k + 2][e0]);
                a[k][e1] = bfhi(r.gb[k][j]) * (wv[0][e1] * y[k][e1] + wv[1][e1] * y[k + 1][e1] + wv[2][e1] * y[k + 2][e1]);
                sq[k] += a[k][e0] * a[k][e0] + a[k][e1] * a[k][e1];
            }
    } else {
#pragma unroll
        for (int k = 0; k < 4; ++k)
#pragma unroll
            for (int j = 0; j < 8; ++j) a[k][j] = 0.f;
    }
#pragma unroll
    for (int o = 32; o >= 1; o >>= 1)
#pragma unroll
        for (int k = 0; k < 4; ++k) sq[k] += __shfl_xor(sq[k], o);
    if (lane < 48) {
#pragma unroll
        for (int k = 0; k < 4; ++k) {
            const float rs = rsqrtf(sq[k] * (1.0f / 384.0f) + EPS);
#pragma unroll
            for (int j = 0; j < 8; ++j) a[k][j] *= rs;
            *(u32x4*)(mix + (size_t)rows[k + 1] * D + lane * 8) = pack8(a[k]);
        }
    }
}
DEV void lds_row_add(const LAS bf16_t* q, float (&S)[8], float sign) {
    const u32x4 v = *(const LAS u32x4*)q;
#pragma unroll
    for (int j = 0; j < 4; ++j) { S[2 * j] += sign * bflo(v[j]); S[2 * j + 1] += sign * bfhi(v[j]); }
}
#define XA_BAR do { asm volatile("s_waitcnt lgkmcnt(0)" ::: "memory"); __builtin_amdgcn_s_barrier(); } while (0)

DEV void xa_tile(const Params& p, int l, const XaTile& t, const XaTile& tn, u32x4 (&st)[8], LAS unsigned char* lds, const bf16x8 (&bfr)[3][3]) {
    unsigned char* ws = p.ws;
    const bf16_t* z = (const bf16_t*)(ws + WS_Z); bf16_t* mix = (bf16_t*)(ws + WS_MIX);
    const float* cw = p.conv_w + (size_t)l * 3 * 384;
    int tid = threadIdx.x; asm volatile("" : "+v"(tid));
    const int wid = tid >> 6, lane = tid & 63, fr = lane & 15, fq = lane >> 4;
    LAS bf16_t* xs = (LAS bf16_t*)lds;
    LAS bf16_t* pre = (LAS bf16_t*)(lds + 80 * 784);
    LAS float* psum = (LAS float*)(lds + 80 * 784 + 64 * 784);
    const int np = t.np, p0 = t.p0, L = t.L, nchunk = (np + 15) * 48;
    ConvRegs cr; int rows[6];
    xa_conv_load(z, t, wid * 8, lane, cr, rows);
#pragma unroll
    for (int j = 0; j < 8; ++j) { const int c = tid + j * NT, i = c / 48, cg8 = c % 48; if (c < nchunk) *(LAS u32x4*)(xs + i * 392 + cg8 * 8) = st[j]; }
    xa_stage_load(z, tn, tid, st);
    XA_BAR;
    if (tid < 384) {
        const int cg8 = tid % 48, seg = tid / 48, gi = cg8 / 12, left = 1 << gi, right = left - 1, t0 = seg * 8;
        if (t0 < np) {
            const LAS bf16_t* col = xs + cg8 * 8;
            float S[8];
#pragma unroll
            for (int j = 0; j < 8; ++j) S[j] = 0.f;
            for (int q = t0 + 8 - left; q <= t0 + 8 + right; ++q) lds_row_add(col + q * 392, S, 1.0f);
#pragma unroll
            for (int k = 0; k < 8; ++k) {
                const int tt = t0 + k, i = tt + 8, pp = p0 + tt;
                const float inv = 1.0f / (float)(min(pp + right, L - 1) - max(pp - left, 0) + 1);
                float o[8];
#pragma unroll
                for (int j = 0; j < 8; ++j) o[j] = S[j] * inv;
                lds_row_add(col + i * 392, o, -1.0f);
                *(LAS u32x4*)(pre + tt * 392 + cg8 * 8) = pack8(o);
                if (k < 7) { lds_row_add(col + (i + right + 1) * 392, S, 1.0f); lds_row_add(col + (i - left) * 392, S, -1.0f); }
            }
        }
    }
    xa_conv_finish(mix, cw, t, wid * 8, lane, cr, rows);
    xa_conv_load(z, t, wid * 8 + 4, lane, cr, rows);
    XA_BAR;
    const int g = wid >> 1, nbh = wid & 1, nmb = np >> 4;
    f32x4 pacc[4][3];
#pragma unroll
    for (int mb = 0; mb < 4; ++mb)
#pragma unroll
        for (int nb = 0; nb < 3; ++nb) pacc[mb][nb] = (f32x4){0.f, 0.f, 0.f, 0.f};
#pragma unroll
    for (int mb = 0; mb < 4; ++mb) {
        if (mb < nmb) {
#pragma unroll
            for (int ks = 0; ks < 3; ++ks) {
                const bf16x8 af = *(const LAS bf16x8*)(pre + (mb * 16 + fr) * 392 + g * 96 + ks * 32 + fq * 8);
#pragma unroll
                for (int nb = 0; nb < 3; ++nb) pacc[mb][nb] = __builtin_amdgcn_mfma_f32_16x16x32_bf16(bfr[nb][ks], af, pacc[mb][nb], 0, 0, 0);
            }
            float q = 0.f;
#pragma unroll
            for (int nb = 0; nb < 3; ++nb) { const f32x4 v = pacc[mb][nb]; q += (v[0] * v[0] + v[1] * v[1]) + (v[2] * v[2] + v[3] * v[3]); }
            q += __shfl_xor(q, 16); q += __shfl_xor(q, 32);
            if (fq == 0) psum[(mb * 16 + fr) * 8 + wid] = q;
        }
    }
    XA_BAR;
#pragma unroll
    for (int mb = 0; mb < 4; ++mb) {
        if (mb < nmb) {
            const f32x4 e0 = *(const LAS f32x4*)(psum + (mb * 16 + fr) * 8), e1 = *(const LAS f32x4*)(psum + (mb * 16 + fr) * 8 + 4);
            const float rs = rsqrtf((((e0[0] + e0[1]) + (e0[2] + e0[3])) + ((e1[0] + e1[1]) + (e1[2] + e1[3]))) * (1.0f / 384.0f) + EPS);
            const int row = rowof(t.s, p0 + mb * 16 + fr);
#pragma unroll
            for (int nb = 0; nb < 3; ++nb) {
                const f32x4 v = pacc[mb][nb] * rs;
                u32x2 w; w.x = cvt_pk_bf16(v[0], v[1]); w.y = cvt_pk_bf16(v[2], v[3]);
                *(u32x2*)(mix + (size_t)row * D + 384 + g * 96 + (nbh * 3 + nb) * 16 + fq * 4) = w;
            }
        }
    }
    xa_conv_finish(mix, cw, t, wid * 8 + 4, lane, cr, rows);
    XA_BAR;
}

DEV void phase_xa(const Params& p, int l, LAS unsigned char* lds) {
    int g0, g1;
    if (gridDim.x == 256) {
        const int b = blockIdx.x, b1 = b + 1;
        const int c0 = b < 64 ? 60 * b : (b < 192 ? 3840 + 140 * (b - 64) : 21760 + 143 * (b - 192));
        const int c1 = b1 < 64 ? 60 * b1 : (b1 < 192 ? 3840 + 140 * (b1 - 64) : 21760 + 143 * (b1 - 192));
        g0 = (int)((long)c0 * NGROUPS / 30912); g1 = (int)((long)c1 * NGROUPS / 30912);
    } else { g0 = (int)((long)blockIdx.x * NGROUPS / gridDim.x); g1 = (int)((long)(blockIdx.x + 1) * NGROUPS / gridDim.x); }
    int tid = threadIdx.x; asm volatile("" : "+v"(tid));
    bf16x8 bfr[3][3];
    {
        const int wid = tid >> 6, lane = tid & 63, fr = lane & 15, fq = lane >> 4, g = wid >> 1, nbh = wid & 1;
        const bf16_t* pw = (const bf16_t*)(p.ws + WS_PW) + (size_t)l * 4 * 96 * 96;
#pragma unroll
        for (int nb = 0; nb < 3; ++nb)
#pragma unroll
            for (int ks = 0; ks < 3; ++ks) bfr[nb][ks] = *(const bf16x8*)(pw + ((size_t)g * 96 + (nbh * 3 + nb) * 16 + fr) * 96 + ks * 32 + fq * 8);
    }
    const bf16_t* z = (const bf16_t*)(p.ws + WS_Z);
    XaTile t = xa_next(g0, g1);
    u32x4 st[8];
    xa_stage_load(z, t, tid, st);
    while (t.np > 0) {
        const XaTile tn = xa_next(g0, g1);
        xa_tile(p, l, t, tn, st, lds, bfr);
        t = tn;
    }
    asm volatile("s_waitcnt vmcnt(0)" ::: "memory");
    __syncthreads();
}

DEV void dft4(float& ar, float& ai, float& br, float& bi, float& cr, float& ci, float& dr, float& di) {
    const float s0r = ar + cr, s0i = ai + ci, d0r = ar - cr, d0i = ai - ci;
    const float s1r = br + dr, s1i = bi + di, d1r = br - dr, d1i = bi - di;
    ar = s0r + s1r; ai = s0i + s1i; cr = s0r - s1r; ci = s0i - s1i;
    br = d0r + d1i; bi = d0i - d1r; dr = d0r - d1i; di = d0i + d1r;
}
DEV void cmulc(float& r, float& i, float c, float s) { const float tr = r * c - i * s, ti = r * s + i * c; r = tr; i = ti; }

DEV void phase_xb(const Params& p, int it0, int itstep) {
    unsigned char* ws = p.ws;
    const bf16_t* z = (const bf16_t*)(ws + WS_Z);
    int tid = threadIdx.x; asm volatile("" : "+v"(tid));
    const int m = tid & 255, half = tid >> 8;
    const int hdc = 1536 + (m >> 6) * 64, ml = m & 63;
    const int cre = hdc + (ml <= 32 ? ml : 64 - ml);
    const int cim = hdc + 32 + ((ml & 31) == 0 ? 1 : (ml < 32 ? ml : 64 - ml));
    const float sgn = (ml & 31) == 0 ? 0.f : (ml < 32 ? 1.f : -1.f);
    for (int it = it0; it < 136 + 8 * 40; it += itstep) {
        int s, gq, L2, KH, N, colbase; const f32x2* tw; bf16_t* wb;
        if (it < 136) { s = 0; gq = it; L2 = L2P; KH = KHP; N = NCP; colbase = 0; tw = (const f32x2*)(ws + WS_TWP); wb = (bf16_t*)((unsigned char*)p.out + OUT_WBP); }
        else { const int j = it - 136; s = 1 + j / 40; gq = j % 40; L2 = L2S; KH = KHS; N = NCS; colbase = (s - 1) * 4096; tw = (const f32x2*)(ws + WS_TWS); wb = (bf16_t*)((unsigned char*)p.out + OUT_WBS); }
        unsigned outr[16][2], outi[16][2];
        bf16_t raw[2][32];
#define XB_LOAD(set, idx) do { const int _n2 = 8 * gq + 4 * half + (idx); \
            if (_n2 < L2) { _Pragma("unroll") for (int n1 = 0; n1 < 16; ++n1) { const bf16_t* q = z + (size_t)rowof(s, L2 * n1 + _n2) * NZ; raw[set][2 * n1] = q[cre]; raw[set][2 * n1 + 1] = q[cim]; } } \
            else { _Pragma("unroll") for (int n1 = 0; n1 < 32; ++n1) raw[set][n1] = 0; } } while (0)
        XB_LOAD(0, 0);
        float pr[2][16], pi[2][16];
#pragma unroll
        for (int idx = 0; idx < 4; ++idx) {
            const int i2 = idx >> 1, i1 = idx & 1, set = idx & 1;
            if (idx < 3) XB_LOAD(set ^ 1, idx + 1);
            SCHED;
            {
                const int n2 = 8 * gq + 4 * half + idx;
                float xr[16], xi[16];
                if (n2 < L2) {
#pragma unroll
                    for (int n1 = 0; n1 < 16; ++n1) { xr[n1] = bf2f(raw[set][2 * n1]); xi[n1] = bf2f(raw[set][2 * n1 + 1]) * sgn; }
#pragma unroll
                    for (int b = 0; b < 4; ++b) dft4(xr[b], xi[b], xr[4 + b], xi[4 + b], xr[8 + b], xi[8 + b], xr[12 + b], xi[12 + b]);
                    const float C1 = 0.92387953251128674f, S1 = 0.38268343236508977f, R2 = 0.70710678118654752f;
                    cmulc(xr[5], xi[5], C1, -S1);
                    cmulc(xr[6], xi[6], R2, -R2);
                    cmulc(xr[7], xi[7], S1, -C1);
                    cmulc(xr[9], xi[9], R2, -R2);
                    cmulc(xr[10], xi[10], 0.f, -1.f);
                    cmulc(xr[11], xi[11], -R2, -R2);
                    cmulc(xr[13], xi[13], S1, -C1);
                    cmulc(xr[14], xi[14], -R2, -R2);
                    cmulc(xr[15], xi[15], -C1, S1);
#pragma unroll
                    for (int c = 0; c < 4; ++c) dft4(xr[4 * c], xi[4 * c], xr[4 * c + 1], xi[4 * c + 1], xr[4 * c + 2], xi[4 * c + 2], xr[4 * c + 3], xi[4 * c + 3]);
#pragma unroll
                    for (int c = 0; c < 4; ++c)
#pragma unroll
                        for (int d = 0; d < 4; ++d) {
                            const int k1 = c + 4 * d;
                            const f32x2 t2 = tw[k1 * KH + n2];
                            const float r = xr[4 * c + d], i = xi[4 * c + d];
                            pr[i1][k1] = r * t2[0] - i * t2[1]; pi[i1][k1] = r * t2[1] + i * t2[0];
                        }
                } else {
#pragma unroll
                    for (int k1 = 0; k1 < 16; ++k1) { pr[i1][k1] = 0.f; pi[i1][k1] = 0.f; }
                }
            }
            if (i1 == 1) {
#pragma unroll
                for (int k1 = 0; k1 < 16; ++k1) { outr[k1][i2] = cvt_pk_bf16(pr[0][k1], pr[1][k1]); outi[k1][i2] = cvt_pk_bf16(pi[0][k1], pi[1][k1]); }
            }
        }
#undef XB_LOAD
#pragma unroll
        for (int k1 = 0; k1 < 16; ++k1) {
            const size_t col = (size_t)colbase + k1 * 256 + m;
            *(u32x2*)(wb + ((size_t)gq * N + col) * 8 + half * 4) = (u32x2){outr[k1][0], outr[k1][1]};
            *(u32x2*)(wb + ((size_t)(KH / 8 + gq) * N + col) * 8 + half * 4) = (u32x2){outi[k1][0], outi[k1][1]};
        }
    }
}

DEV void phase_final(const Params& p) {
    const float* ss = (const float*)(p.ws + WS_SS1);
    const bf16_t* hb = (const bf16_t*)(p.ws + WS_HB);
    int tid = threadIdx.x; asm volatile("" : "+v"(tid));
    const int lane = tid & 63;
    const int gw = (int)(((long)blockIdx.x * NT + tid) >> 6), nw = (int)(((long)gridDim.x * NT) >> 6);
    const f32x4 g00 = *(const f32x4*)(p.final_g + lane * 8), g01 = *(const f32x4*)(p.final_g + lane * 8 + 4);
    const f32x4 g10 = *(const f32x4*)(p.final_g + 512 + lane * 8), g11 = *(const f32x4*)(p.final_g + 512 + lane * 8 + 4);
    for (int r0 = gw * 2; r0 < TX; r0 += nw * 2) {
        u32x4 h[2][2]; float rs[2];
#pragma unroll
        for (int q = 0; q < 2; ++q) {
            rs[q] = row_rs(ss, r0 + q);
#pragma unroll
            for (int j = 0; j < 2; ++j) h[q][j] = *(const u32x4*)(hb + (size_t)(r0 + q) * D + j * 512 + lane * 8);
        }
#pragma unroll
        for (int q = 0; q < 2; ++q) {
            float* o = p.out + (size_t)(r0 + q) * D + lane * 8;
            const float s0 = rs[q];
            *(f32x4*)(o) = (f32x4){bflo(h[q][0].x) * s0 * g00[0], bfhi(h[q][0].x) * s0 * g00[1], bflo(h[q][0].y) * s0 * g00[2], bfhi(h[q][0].y) * s0 * g00[3]};
            *(f32x4*)(o + 4) = (f32x4){bflo(h[q][0].z) * s0 * g01[0], bfhi(h[q][0].z) * s0 * g01[1], bflo(h[q][0].w) * s0 * g01[2], bfhi(h[q][0].w) * s0 * g01[3]};
            *(f32x4*)(o + 512) = (f32x4){bflo(h[q][1].x) * s0 * g10[0], bfhi(h[q][1].x) * s0 * g10[1], bflo(h[q][1].y) * s0 * g10[2], bfhi(h[q][1].y) * s0 * g10[3]};
            *(f32x4*)(o + 516) = (f32x4){bflo(h[q][1].z) * s0 * g11[0], bfhi(h[q][1].z) * s0 * g11[1], bflo(h[q][1].w) * s0 * g11[2], bfhi(h[q][1].w) * s0 * g11[3]};
        }
    }
}

#define XB_TMO      128
#define XB_XCNT(j)  (256  + 64 * (j))
#define XB_XSUB(j)  (1280 + 64 * (j))
#define XB_XGEN(j)  (2304 + 64 * (j))
#define XB_TOP      3328
#define XB_TOPGEN   3392
#define XCD_BAR_WORDS 3456
#define XB_SPIN_CAP (1u << 18)
DEV unsigned xb_ld(unsigned* p) { return __hip_atomic_load(p, __ATOMIC_RELAXED, __HIP_MEMORY_SCOPE_AGENT); }
DEV unsigned xb_add(unsigned* p, unsigned v) { return __hip_atomic_fetch_add(p, v, __ATOMIC_RELAXED, __HIP_MEMORY_SCOPE_AGENT); }
DEV unsigned xb_xcc_id() { return (unsigned)__builtin_amdgcn_s_getreg((3 << 11) | 20) & 0xFu; }
#define XB_SPIN(cond, bar) do { unsigned _sp = 0; while (cond) { __builtin_amdgcn_s_sleep(1); \
    if ((++_sp & 255u) == 0u) { if (xb_ld(&(bar)[XB_TMO])) break; if (_sp > XB_SPIN_CAP) { atomicAdd(&(bar)[XB_TMO], 1u); break; } } } } while (0)
struct XcdBarrier { unsigned* bar; unsigned x; volatile LAS unsigned* st; };
DEV XcdBarrier xcd_barrier_post(unsigned* bar, volatile LAS unsigned* st) {
    XcdBarrier b; b.bar = bar; b.x = xb_xcc_id(); b.st = st;
    if (threadIdx.x == 0) (void)xb_add(&bar[XB_XCNT(b.x)], 1u);
    return b;
}
DEV void xcd_barrier_complete(unsigned* bar, unsigned x, unsigned& nloc, unsigned& nx) {
    const unsigned G = gridDim.x * gridDim.y * gridDim.z;
    unsigned sum, cnt, mine, sp = 0u;
    for (;;) {
        sum = 0u; cnt = 0u; mine = 0u;
#pragma unroll
        for (unsigned j = 0; j < 16; ++j) { const unsigned c = xb_ld(&bar[XB_XCNT(j)]); sum += c; cnt += (c > 0u) ? 1u : 0u; mine = (j == x) ? c : mine; }
        if (sum == G) break;
        __builtin_amdgcn_s_sleep(1);
        if ((++sp & 255u) == 0u) { if (xb_ld(&bar[XB_TMO])) break; if (sp > XB_SPIN_CAP) { atomicAdd(&bar[XB_TMO], 1u); break; } }
    }
    nloc = mine > 0u ? mine : 1u; nx = cnt > 0u ? cnt : 1u;
}
DEV void xcd_barrier(const XcdBarrier& b) {
    asm volatile("s_waitcnt vmcnt(0)" ::: "memory");
    __syncthreads();
    if (threadIdx.x == 0) {
        unsigned* bar = b.bar;
        __builtin_amdgcn_s_waitcnt(0);
        unsigned nloc = b.st[0], nx = b.st[1];
        if (nloc == 0u) { xcd_barrier_complete(bar, b.x, nloc, nx); b.st[0] = nloc; b.st[1] = nx; }
        const unsigned old = xb_add(&bar[XB_XSUB(b.x)], 1u);
        const unsigned gen = old / nloc;
        if (old + 1u == (gen + 1u) * nloc) {
            __builtin_amdgcn_fence(__ATOMIC_RELEASE, "agent");
            asm volatile("s_waitcnt vmcnt(0)" ::: "memory");
            const unsigned og = xb_add(&bar[XB_TOP], 1u);
            const unsigned tg = og / nx;
            if (og + 1u == (tg + 1u) * nx) xb_add(&bar[XB_TOPGEN], 1u);
            else XB_SPIN(xb_ld(&bar[XB_TOPGEN]) == tg, bar);
            __builtin_amdgcn_fence(__ATOMIC_ACQUIRE, "agent");
            xb_add(&bar[XB_XGEN(b.x)], 1u);
            asm volatile("s_waitcnt vmcnt(0)" ::: "memory");
        } else {
            XB_SPIN(xb_ld(&bar[XB_XGEN(b.x)]) == gen, bar);
            __builtin_amdgcn_fence(__ATOMIC_ACQUIRE, "agent");
            asm volatile("s_waitcnt vmcnt(0)" ::: "memory");
        }
    }
    __syncthreads();
}

#if MEGA
__global__ void __launch_bounds__(NT, 2) fwd_mega(Params p) {
    extern __shared__ __attribute__((aligned(16))) unsigned char lds_raw[];
    LAS unsigned char* lds = (LAS unsigned char*)lds_raw;
    cg::grid_group grid = cg::this_grid();
    if (threadIdx.x < 4) ((LAS unsigned*)(lds + LDS_CTL))[threadIdx.x] = 0u;
    __syncthreads();
    XcdBarrier bar = xcd_barrier_post((unsigned*)(p.ws + WS_BAR), (volatile LAS unsigned*)(lds + LDS_CTL));
    phase_prologue(p, lds);
    if (p.ws == nullptr) grid.sync();
    xcd_barrier(bar);
    for (int l = 0; l < DEPTH; ++l) {
        phase_gemm1(p, l, lds); xcd_barrier(bar);
        phase_dft(p, lds); phase_xa(p, l, lds); xcd_barrier(bar);
        phase_gemm2(p, l, lds); xcd_barrier(bar);
        phase_gemm3(p, l, lds); xcd_barrier(bar);
        phase_gemm4(p, l, lds); xcd_barrier(bar);
    }
    phase_final(p);
}
#else
template <int PH> __global__ void __launch_bounds__(NT, 2) phase_kernel(Params p, int l) {
    extern __shared__ __attribute__((aligned(16))) unsigned char lds_raw[];
    LAS unsigned char* lds = (LAS unsigned char*)lds_raw;
    if (PH == 0) phase_prologue(p, lds);
    if (PH == 1) phase_gemm1(p, l, lds);
    if (PH == 2) {}
    if (PH == 3) { phase_dft(p, lds); phase_xa(p, l, lds); }
    if (PH == 4) phase_gemm2(p, l, lds);
    if (PH == 5) phase_gemm3(p, l, lds);
    if (PH == 6) phase_gemm4(p, l, lds);
    if (PH == 7) phase_final(p);
}
template <int PH> static void launch_phase(const Params& p, int l, hipStream_t stream) {
    static bool attr = false;
    if (!attr) { (void)hipFuncSetAttribute((const void*)phase_kernel<PH>, hipFuncAttributeMaxDynamicSharedMemorySize, LDS_BYTES); attr = true; }
    hipLaunchKernelGGL(phase_kernel<PH>, dim3(256), dim3(NT), LDS_BYTES, stream, p, l);
}
#endif

extern "C" void kernel_launch(void* const* d_in, const int* in_sizes, int n_in, void* d_out, int out_size, void* d_ws, size_t ws_size, hipStream_t stream) {
    if (n_in != 14 || ws_size < WS_END || out_size != TX * D) { fprintf(stderr, "kernel_launch: unexpected shapes (n_in %d, ws %zu need %zu, out %d)\n", n_in, ws_size, (size_t)WS_END, out_size); return; }
    Params p{};
    p.x_prompt = (const float*)d_in[0]; p.x_sample = (const float*)d_in[1]; p.meta = (const float*)d_in[2]; p.norm1_g = (const float*)d_in[3];
    p.w_in = (const float*)d_in[4]; p.conv_w = (const float*)d_in[5]; p.pool_w = (const float*)d_in[6]; p.pool_scale = (const float*)d_in[7];
    p.mix_g = (const float*)d_in[8]; p.w_out = (const float*)d_in[9]; p.norm2_g = (const float*)d_in[10]; p.w_gate_up = (const float*)d_in[11];
    p.w_down = (const float*)d_in[12]; p.final_g = (const float*)d_in[13];
    p.out = (float*)d_out; p.ws = (unsigned char*)d_ws;
#if MEGA
    static int grid = 0;
    if (grid == 0) {
        int dev = 0, cus = 0, per_cu = 0;
        (void)hipGetDevice(&dev);
        (void)hipDeviceGetAttribute(&cus, hipDeviceAttributeMultiprocessorCount, dev);
        (void)hipFuncSetAttribute((const void*)fwd_mega, hipFuncAttributeMaxDynamicSharedMemorySize, LDS_BYTES);
        (void)hipOccupancyMaxActiveBlocksPerMultiprocessor(&per_cu, (const void*)fwd_mega, NT, LDS_BYTES);
        if (per_cu < 1) per_cu = 1;
        grid = cus * per_cu;
        if (grid > 256) grid = 256;
    }
    (void)hipMemsetAsync((unsigned char*)d_ws + WS_BAR, 0, XCD_BAR_WORDS_C * 4, stream);
    void* args[] = {&p};
    hipError_t e = hipLaunchCooperativeKernel((const void*)fwd_mega, dim3(grid), dim3(NT), args, LDS_BYTES, stream);
    if (e != hipSuccess) fprintf(stderr, "cooperative launch failed: %s (grid %d)\n", hipGetErrorString(e), grid);
#else
    launch_phase<0>(p, 0, stream);
    for (int l = 0; l < DEPTH; ++l) {
        launch_phase<1>(p, l, stream); launch_phase<2>(p, l, stream); launch_phase<3>(p, l, stream);
        launch_phase<4>(p, l, stream); launch_phase<5>(p, l, stream); launch_phase<6>(p, l, stream);
    }
    launch_phase<7>(p, 0, stream);
#endif
}
```

```cpp
#include <hip/hip_runtime.h>
#include <hip/hip_cooperative_groups.h>
#include <cstdio>
#include <cstdint>
namespace cg = cooperative_groups;

#ifndef MEGA
#define MEGA 1
#endif

#define LAS __attribute__((address_space(3)))
#define DEV __device__ __forceinline__
typedef unsigned short bf16_t;
typedef short bf16x8 __attribute__((ext_vector_type(8)));
typedef float f32x4 __attribute__((ext_vector_type(4)));
typedef float f32x2 __attribute__((ext_vector_type(2)));
typedef unsigned u32x4 __attribute__((ext_vector_type(4)));
typedef unsigned u32x2 __attribute__((ext_vector_type(2)));

constexpr int D = 1024, NZ = 2048, DFF = 2816, NGU = 5632, DEPTH = 4, NIN0 = 1792;
constexpr int TX = 49152, TMETA = 144, T = TX + TMETA, TP = TX + 256;
constexpr int LP = 16400, LS = 4112, L2P = 1025, L2S = 257;
constexpr int KHP = 1088, KHS = 320, KP = 2 * KHP, KS = 2 * KHS, MPP = 1280, MPS = 512;
constexpr int NCP = 4096, NCS = 32768;
constexpr int NGROUPS = 3081;
constexpr float EPS = 1e-6f;
constexpr int LDS_BYTES = 131072 + 8192 + 16;
constexpr int NT = 512;
constexpr int XCD_BAR_WORDS_C = 3456 + 256;
constexpr int VCNT_WORD0 = 3456;
constexpr int MCNT_WORD0 = 3456 + 32;
constexpr int NVTILES = 192 + 9;
constexpr int LDS_EX = 131072;
constexpr int LDS_CTL = 131072 + 8192;

constexpr size_t al(size_t x) { return (x + 255) & ~size_t(255); }
constexpr size_t WS_W1 = 0;
constexpr size_t WS_W2 = WS_W1 + al((size_t)DEPTH * NZ * D * 2);
constexpr size_t WS_W3 = WS_W2 + al((size_t)DEPTH * D * D * 2);
constexpr size_t WS_W4 = WS_W3 + al((size_t)DEPTH * NGU * D * 2);
constexpr size_t WS_PW = WS_W4 + al((size_t)DEPTH * D * DFF * 2);
constexpr size_t WS_DP = WS_PW + al((size_t)DEPTH * 4 * 96 * 96 * 2);
constexpr size_t WS_DS = WS_DP + al((size_t)MPP * KP * 2);
constexpr size_t WS_TWP = WS_DS + al((size_t)MPS * KS * 2);
constexpr size_t WS_TWS = WS_TWP + al((size_t)16 * KHP * 8);
constexpr size_t WS_SS1 = WS_TWS + al((size_t)16 * KHS * 8);
constexpr size_t WS_SS2 = WS_SS1 + al((size_t)TP * 4 * 4);
constexpr size_t WS_HM = WS_SS2 + al((size_t)TP * 4 * 4);
constexpr size_t WS_HB = WS_HM + al((size_t)256 * D * 4);
constexpr size_t WS_Z = WS_HB + al((size_t)TP * D * 2);
constexpr size_t WS_MIX = WS_Z + al((size_t)TP * NZ * 2);
constexpr size_t WS_BAR = WS_MIX + al((size_t)TP * D * 2);
constexpr size_t WS_END = WS_BAR + al((size_t)XCD_BAR_WORDS_C * 4);
constexpr size_t OUT_WBP = 0;
constexpr size_t OUT_WBS = (size_t)KP * NCP * 2;
constexpr size_t WS_ACT = WS_Z;
static_assert((size_t)KP * NCP * 2 + (size_t)KS * NCS * 2 <= (size_t)TX * D * 4, "WB in d_out");
static_assert((size_t)TP * DFF * 2 <= (WS_BAR - WS_Z), "ACT overlay");

struct Params {
    const float *x_prompt, *x_sample, *meta, *norm1_g, *w_in, *conv_w, *pool_w, *pool_scale, *mix_g, *w_out, *norm2_g, *w_gate_up, *w_down, *final_g;
    float* out; unsigned char* ws;
};

DEV unsigned cvt_pk_bf16(float lo, float hi) { unsigned r; asm("v_cvt_pk_bf16_f32 %0, %1, %2" : "=v"(r) : "v"(lo), "v"(hi)); return r; }
DEV float bflo(unsigned w) { return __uint_as_float(w << 16); }
DEV float bfhi(unsigned w) { return __uint_as_float(w & 0xffff0000u); }
DEV float bf2f(bf16_t v) { return __uint_as_float((unsigned)v << 16); }

DEV u32x4 pack8(const float (&v)[8]) { u32x4 w; w.x = cvt_pk_bf16(v[0], v[1]); w.y = cvt_pk_bf16(v[2], v[3]); w.z = cvt_pk_bf16(v[4], v[5]); w.w = cvt_pk_bf16(v[6], v[7]); return w; }

typedef __amdgpu_buffer_rsrc_t rsrc_t;
DEV rsrc_t make_rsrc(const void* base, unsigned bytes) { return __builtin_amdgcn_make_buffer_rsrc((void*)base, 0, (int)bytes, 0x00020000); }
DEV void st16_wt(rsrc_t r, unsigned byte_off, u32x4 v) { __builtin_amdgcn_raw_buffer_store_b128(v, r, byte_off, 0, 16); }

DEV int seq_xbase(int s) { return s == 0 ? 0 : 16384 + 4096 * (s - 1); }
DEV int rowof(int s, int p) { return p < 16 ? TX + 16 * s + p : seq_xbase(s) + p - 16; }

DEV int swz_off(int fr, int fq) { int ob = fr * 64 + fq * 16; return ob ^ (((ob >> 9) & 1) << 5); }
DEV void stage_rc(int b, int& R, int& C) { int st = b >> 10, sb = b & 1023, swz = sb ^ (((sb >> 9) & 1) << 5); R = (st >> 1) * 16 + (swz >> 6); C = (st & 1) * 32 + ((swz & 63) >> 1); }

#define GLDS(g, l) __builtin_amdgcn_global_load_lds((const unsigned*)(g), (LAS unsigned*)(l), 16, 0, 0)
#define WAIT_V(n) asm volatile("s_waitcnt vmcnt(" #n ")" ::: "memory")
#define WAIT_L(n) asm volatile("s_waitcnt lgkmcnt(" #n ")" ::: "memory")
#define BAR __builtin_amdgcn_s_barrier()
#define SCHED __builtin_amdgcn_sched_barrier(0)

template <int BMODE, class Epi, class TileFn>
DEV void gemm_loop(LAS unsigned char* lds, const bf16_t* __restrict__ A, int lda, const bf16_t* __restrict__ B, int ldb, int K, const Epi& epi, int t0, int tstep, int tend, const TileFn& tf) {
    if (t0 >= tend) return;
    int tid = threadIdx.x; asm volatile("" : "+v"(tid));
    const int wid = tid >> 6, lane = tid & 63, wr = wid >> 2, wc = wid & 3, fr = lane & 15, fq = lane >> 4;
    int r0, c0; stage_rc(tid * 16, r0, c0);
    const unsigned voa0 = (unsigned)(r0 * lda + c0) * 2u, voa1 = voa0 + (unsigned)(64 * lda) * 2u;
    const size_t ahalf = (size_t)128 * lda * 2;
    unsigned vob0, vob1; size_t bks, bhalf;
    const int r0b = Epi::PERM ? ((r0 & ~31) + 8 * ((r0 & 15) >> 2) + 4 * ((r0 >> 4) & 1) + (r0 & 3)) : r0;
    if (BMODE == 0) { vob0 = (unsigned)(r0b * ldb + c0) * 2u; vob1 = vob0 + (unsigned)(64 * ldb) * 2u; bks = 128; bhalf = (size_t)128 * ldb * 2; }
    else { vob0 = (unsigned)((c0 >> 3) * ldb + r0b) * 16u; vob1 = vob0 + 64u * 16u; bks = (size_t)ldb * 128; bhalf = 128 * 16; }
    LAS unsigned char* lw = lds + tid * 16;
    const int sw = swz_off(fr, fq);
    LAS unsigned char* la = lds + wr * 8192 + sw;
    LAS unsigned char* lb = lds + 65536 + wc * 4096 + sw;
    int brow, bcol; tf(t0, brow, bcol);
    const char* cA = (const char*)(A + (size_t)brow * lda);
    const char* cB = BMODE == 0 ? (const char*)(B + (size_t)bcol * ldb) : (const char*)(B + (size_t)bcol * 8);

#define STG_A(b, h, ptr) do { const char* _g = (ptr) + (h) * ahalf; LAS unsigned char* _l = lw + ((b) * 2 + (h)) * 16384; GLDS(_g + voa0, _l); GLDS(_g + voa1, _l + 8192); } while (0)
#define STG_B(b, h, ptr) do { const char* _g = (ptr) + (h) * bhalf; LAS unsigned char* _l = lw + 65536 + ((b) * 2 + (h)) * 16384; GLDS(_g + vob0, _l); GLDS(_g + vob1, _l + 8192); } while (0)
#define LDA(dst, b, h) _Pragma("unroll") for (int m = 0; m < 4; ++m) _Pragma("unroll") for (int k = 0; k < 2; ++k) dst[m][k] = *(const LAS bf16x8*)(la + ((b) * 2 + (h)) * 16384 + m * 2048 + k * 1024)
#define LDB(dst, b, h) _Pragma("unroll") for (int n = 0; n < 2; ++n) _Pragma("unroll") for (int k = 0; k < 2; ++k) dst[n][k] = *(const LAS bf16x8*)(lb + ((b) * 2 + (h)) * 16384 + n * 2048 + k * 1024)
#define MMA(ai, bj, Af, Bf) do { __builtin_amdgcn_s_setprio(1); \
    _Pragma("unroll") for (int m = 0; m < 4; ++m) _Pragma("unroll") for (int n = 0; n < 2; ++n) _Pragma("unroll") for (int k = 0; k < 2; ++k) \
        acc[ai][bj][m][n] = __builtin_amdgcn_mfma_f32_16x16x32_bf16(Bf[n][k], Af[m][k], acc[ai][bj][m][n], 0, 0, 0); \
    __builtin_amdgcn_s_setprio(0); } while (0)

    const int nt = K / 64;
    f32x4 acc[2][2][4][2];
#pragma unroll
    for (int a = 0; a < 2; ++a)
#pragma unroll
        for (int b = 0; b < 2; ++b)
#pragma unroll
            for (int m = 0; m < 4; ++m)
#pragma unroll
                for (int n = 0; n < 2; ++n) acc[a][b][m][n] = (f32x4){0.f, 0.f, 0.f, 0.f};
    bf16x8 At[4][2], B0[2][2], B1[2][2];
    STG_B(0, 0, cB); STG_B(0, 1, cB); STG_A(0, 0, cA); STG_A(0, 1, cA);
    if (wr == 1) BAR;
    WAIT_V(2); BAR;
    STG_B(1, 0, cB + bks); STG_A(1, 0, cA + 128); STG_B(1, 1, cB + bks);
    WAIT_V(6); BAR;
    int par = 0;
    for (int tt = t0;; tt += tstep, par ^= 1) {
        const bool has_next = tt + tstep < tend;
        epi.prefetch(lds, brow, par, tid);
        int nrow = brow, ncol = bcol;
        if (has_next) tf(tt + tstep, nrow, ncol);
        const char* nA = (const char*)(A + (size_t)nrow * lda);
        const char* nB = BMODE == 0 ? (const char*)(B + (size_t)ncol * ldb) : (const char*)(B + (size_t)ncol * 8);
        for (int t = 0; t < nt; t += 2) {
            const bool last = (t == nt - 2);
            const char* a1 = cA + (size_t)(t + 1) * 128;
            const char* a2 = last ? nA : cA + (size_t)(t + 2) * 128;
            const char* b2 = last ? nB : cB + (size_t)(t + 2) * bks;
            const char* a3 = a2 + 128; const char* b3 = b2 + bks;
            LDB(B0, 0, 0); LDB(B1, 0, 1); SCHED; LDA(At, 0, 0); STG_A(1, 1, a1);
            WAIT_V(8); WAIT_L(0); BAR; MMA(0, 0, At, B0); MMA(0, 1, At, B1); BAR; SCHED;
            LDA(At, 0, 1); STG_B(0, 0, b2); STG_B(0, 1, b2); STG_A(0, 0, a2);
            WAIT_V(8); WAIT_L(0); BAR; MMA(1, 0, At, B0); MMA(1, 1, At, B1); BAR; SCHED;
            LDB(B0, 1, 0); LDB(B1, 1, 1); SCHED; LDA(At, 1, 0); STG_A(0, 1, a2);
            WAIT_V(8); WAIT_L(0); BAR; MMA(0, 0, At, B0); MMA(0, 1, At, B1); BAR; SCHED;
            LDA(At, 1, 1); STG_B(1, 0, b3); STG_B(1, 1, b3); STG_A(1, 0, a3);
            WAIT_V(8); WAIT_L(0); BAR; MMA(1, 0, At, B0); MMA(1, 1, At, B1); BAR; SCHED;
        }
        if (wr == 0) BAR;
        epi(acc, brow, bcol, lds, par);
        if (!has_next) break;
#pragma unroll
        for (int a = 0; a < 2; ++a)
#pragma unroll
            for (int b = 0; b < 2; ++b)
#pragma unroll
                for (int m = 0; m < 4; ++m)
#pragma unroll
                    for (int n = 0; n < 2; ++n) acc[a][b][m][n] = (f32x4){0.f, 0.f, 0.f, 0.f};
        brow = nrow; bcol = ncol; cA = nA; cB = nB;
        if (wr == 1) BAR;
    }
    WAIT_V(0);
    BAR;
#undef STG_A
#undef STG_B
#undef LDA
#undef LDB
#undef MMA
}

DEV void skinny_reduce(LAS unsigned char* lds, int wid, int lane, const f32x4 (&acc)[16], f32x4& a0, f32x4& a1) {
#pragma unroll
    for (int nb = 0; nb < 16; ++nb) *(LAS f32x4*)(lds + ((wid * 16 + nb) * 64 + lane) * 16) = acc[nb];
    __syncthreads();
    a0 = (f32x4){0.f, 0.f, 0.f, 0.f}; a1 = a0;
#pragma unroll
    for (int w = 0; w < 8; ++w) { a0 += *(const LAS f32x4*)(lds + ((w * 16 + 2 * wid) * 64 + lane) * 16); a1 += *(const LAS f32x4*)(lds + ((w * 16 + 2 * wid + 1) * 64 + lane) * 16); }
    __syncthreads();
}
template <class Epi>
DEV void skinny_item(LAS unsigned char* lds, const bf16_t* __restrict__ A, int lda, const bf16_t* __restrict__ B, int ldb, int K, int mb, int pn, const Epi& epi) {
    int tid = threadIdx.x; asm volatile("" : "+v"(tid));
    const int wid = tid >> 6, lane = tid & 63, fr = lane & 15, fq = lane >> 4;
    const bf16_t* ap = A + (size_t)(TX + mb * 16 + fr) * lda + fq * 8;
    const bf16_t* bp = B + (size_t)(pn * 256 + fr) * ldb + fq * 8;
    const size_t b16 = (size_t)16 * ldb;
    f32x4 acc[16];
#pragma unroll
    for (int nb = 0; nb < 16; ++nb) acc[nb] = (f32x4){0.f, 0.f, 0.f, 0.f};
    const int nsteps = K >> 5;
#pragma unroll 1
    for (int st = wid; st < nsteps; st += 8) {
        const int k0 = st * 32;
        const bf16x8 a = *(const bf16x8*)(ap + k0);
        bf16x8 b[16];
#pragma unroll
        for (int nb = 0; nb < 16; ++nb) b[nb] = *(const bf16x8*)(bp + nb * b16 + k0);
        SCHED;
#pragma unroll
        for (int nb = 0; nb < 16; ++nb) acc[nb] = __builtin_amdgcn_mfma_f32_16x16x32_bf16(b[nb], a, acc[nb], 0, 0, 0);
        SCHED;
    }
    f32x4 a0, a1;
    skinny_reduce(lds, wid, lane, acc, a0, a1);
    epi.skinny(a0, a1, mb, pn, lds);
}

template <class Epi>
DEV void skinny_dft(LAS unsigned char* lds, const bf16_t* __restrict__ A, int lda, const bf16_t* __restrict__ B, int N, int K, int arow0, int ncol0, const Epi& epi) {
    int tid = threadIdx.x; asm volatile("" : "+v"(tid));
    const int wid = tid >> 6, lane = tid & 63, fr = lane & 15, fq = lane >> 4;
    const bf16_t* ap = A + (size_t)(arow0 + fr) * lda + fq * 8;
    const bf16_t* bp = B + ((size_t)fq * N + ncol0 + fr) * 8;
    const size_t bstep = (size_t)4 * N * 8;
    f32x4 acc[16];
#pragma unroll
    for (int nb = 0; nb < 16; ++nb) acc[nb] = (f32x4){0.f, 0.f, 0.f, 0.f};
    const int nsteps = K >> 5;
#pragma unroll 1
    for (int st = wid; st < nsteps; st += 8) {
        const bf16x8 a = *(const bf16x8*)(ap + st * 32);
        const bf16_t* bq = bp + st * bstep;
        bf16x8 b[16];
#pragma unroll
        for (int nb = 0; nb < 16; ++nb) b[nb] = *(const bf16x8*)(bq + nb * 128);
        SCHED;
#pragma unroll
        for (int nb = 0; nb < 16; ++nb) acc[nb] = __builtin_amdgcn_mfma_f32_16x16x32_bf16(b[nb], a, acc[nb], 0, 0, 0);
        SCHED;
    }
    f32x4 a0, a1;
    skinny_reduce(lds, wid, lane, acc, a0, a1);
    epi.skinny(a0, a1, lds);
}

struct TileMap { int nM, nN; DEV void operator()(int t, int& brow, int& bcol) const; };
struct TileMapRev { int nM, nN; DEV void operator()(int t, int& brow, int& bcol) const; };
struct TileG1 { DEV void operator()(int t, int& brow, int& bcol) const; };
struct TileOne { int brow_, bcol_; DEV void operator()(int, int& brow, int& bcol) const { brow = brow_; bcol = bcol_; } };

DEV void tile_map(int L, int nM, int nN, int& pm, int& pn) {
    const int nwg = nM * nN; int wgid = L;
    { const int q = nwg / 8, r = nwg % 8, xcd = wgid % 8, off = wgid / 8; wgid = (xcd < r ? xcd * (q + 1) : r * (q + 1) + (xcd - r) * q) + off; }
    const int nig = 4 * nN, gid = wgid / nig, fm = gid * 4, gsz = (nM - fm) < 4 ? (nM - fm) : 4;
    pm = fm + ((wgid % nig) % gsz); pn = (wgid % nig) / gsz;
}

DEV void TileMap::operator()(int t, int& brow, int& bcol) const { int pm, pn; tile_map(t, nM, nN, pm, pn); brow = pm * 256; bcol = pn * 256; }
DEV void TileG1::operator()(int t, int& brow, int& bcol) const { int pm, pn; tile_map(t, 192, 7, pm, pn); brow = pm * 256; bcol = (pn == 0 ? 6 : pn - 1) * 256; }
DEV void TileMapRev::operator()(int t, int& brow, int& bcol) const { int pm, pn; tile_map(t, nM, nN, pm, pn); brow = (nM - 1 - pm) * 256; bcol = pn * 256; }

#define EPI_IDS int tid = threadIdx.x; asm volatile("" : "+v"(tid)); const int wid = tid >> 6, lane = tid & 63, wr = wid >> 2, wc = wid & 3, fr = lane & 15, fq = lane >> 4; (void)wc; (void)fq; (void)fr; (void)wr;

DEV float row_rs(const float* ss, int row) { const f32x4 s4 = *(const f32x4*)(ss + (size_t)row * 4); return rsqrtf(((s4[0] + s4[1]) + (s4[2] + s4[3])) * (1.0f / 1024.0f) + EPS); }

struct Epi1 {
    static constexpr bool PERM = true;
    bf16_t* z; const float* ss; unsigned* vcnt;
    DEV void prefetch(LAS unsigned char* lds, int brow, int par, int tid) const { if (tid < 256) GLDS(ss + (size_t)(brow + tid) * 4, lds + LDS_EX + par * 4096 + tid * 16); }
    DEV void publish(int tid) const {
        asm volatile("s_waitcnt vmcnt(0)" ::: "memory");
        __syncthreads();
        if (tid == 0) (void)__hip_atomic_fetch_add(vcnt, 1u, __ATOMIC_RELAXED, __HIP_MEMORY_SCOPE_AGENT);
    }
    DEV void publish_fenced(int tid) const {
        asm volatile("s_waitcnt vmcnt(0)" ::: "memory");
        __syncthreads();
        if (tid == 0) { __builtin_amdgcn_fence(__ATOMIC_RELEASE, "agent"); asm volatile("s_waitcnt vmcnt(0)" ::: "memory"); (void)__hip_atomic_fetch_add(vcnt, 1u, __ATOMIC_RELAXED, __HIP_MEMORY_SCOPE_AGENT); }
    }
    DEV void operator()(f32x4 (&acc)[2][2][4][2], int brow, int bcol, LAS unsigned char* lds, int par) const {
        EPI_IDS
        const rsrc_t zr = make_rsrc(z, (unsigned)((size_t)TP * NZ * 2));
        const bool vt = bcol == 6 * 256;
#pragma unroll
        for (int ai = 0; ai < 2; ++ai)
#pragma unroll
            for (int m = 0; m < 4; ++m) {
                const int lr = ai * 128 + wr * 64 + m * 16 + fr, row = brow + lr;
                const f32x4 s4 = *(const LAS f32x4*)(lds + LDS_EX + par * 4096 + lr * 16);
                const float rs = rsqrtf(((s4[0] + s4[1]) + (s4[2] + s4[3])) * (1.0f / 1024.0f) + EPS);
#pragma unroll
                for (int bj = 0; bj < 2; ++bj) {
                    const f32x4 v0 = acc[ai][bj][m][0] * rs, v1 = acc[ai][bj][m][1] * rs;
                    u32x4 w; w.x = cvt_pk_bf16(v0[0], v0[1]); w.y = cvt_pk_bf16(v0[2], v0[3]); w.z = cvt_pk_bf16(v1[0], v1[1]); w.w = cvt_pk_bf16(v1[2], v1[3]);
                    if (vt) st16_wt(zr, (unsigned)(row * NZ + bcol + bj * 128 + wc * 32 + fq * 8) * 2u, w);
                    else *(u32x4*)(z + (size_t)row * NZ + bcol + bj * 128 + wc * 32 + fq * 8) = w;
                }
            }
        if (vt) publish(tid);
    }
    DEV void skinny(f32x4 a0, f32x4 a1, int mb, int pn, LAS unsigned char*) const {
        EPI_IDS
        const int row = TX + mb * 16 + fr;
        const float rs = row_rs(ss, row);
        const f32x4 v0 = a0 * rs, v1 = a1 * rs;
        bf16_t* zp = z + (size_t)row * NZ + pn * 256 + wid * 32 + fq * 4;
        *(u32x2*)zp = (u32x2){cvt_pk_bf16(v0[0], v0[1]), cvt_pk_bf16(v0[2], v0[3])};
        *(u32x2*)(zp + 16) = (u32x2){cvt_pk_bf16(v1[0], v1[1]), cvt_pk_bf16(v1[2], v1[3])};
        if (pn == 6) publish_fenced(tid);
    }
};

struct EpiRes {
    static constexpr bool PERM = true;
    bf16_t* hb; float* ssout;
    DEV void prefetch(LAS unsigned char*, int, int, int) const {}
    DEV void operator()(f32x4 (&acc)[2][2][4][2], int brow, int bcol, LAS unsigned char* lds, int) const {
        EPI_IDS
        LAS float* ex = (LAS float*)(lds + LDS_EX);
        bf16_t* hp0 = hb + (size_t)(brow + wr * 64 + fr) * D + bcol + wc * 32 + fq * 8;
        u32x4 res[2][4][2];
#pragma unroll
        for (int ai = 0; ai < 2; ++ai)
#pragma unroll
            for (int m = 0; m < 4; ++m)
#pragma unroll
                for (int bj = 0; bj < 2; ++bj) res[ai][m][bj] = *(const u32x4*)(hp0 + (size_t)(ai * 128 + m * 16) * D + bj * 128);
        SCHED;
#pragma unroll
        for (int ai = 0; ai < 2; ++ai)
#pragma unroll
            for (int m = 0; m < 4; ++m) {
                const int lr = ai * 128 + wr * 64 + m * 16 + fr;
                float s = 0.f;
#pragma unroll
                for (int bj = 0; bj < 2; ++bj) {
                    const u32x4 r = res[ai][m][bj];
                    f32x4 v0 = acc[ai][bj][m][0], v1 = acc[ai][bj][m][1];
                    v0[0] += bflo(r.x); v0[1] += bfhi(r.x); v0[2] += bflo(r.y); v0[3] += bfhi(r.y);
                    v1[0] += bflo(r.z); v1[1] += bfhi(r.z); v1[2] += bflo(r.w); v1[3] += bfhi(r.w);
                    u32x4 w; w.x = cvt_pk_bf16(v0[0], v0[1]); w.y = cvt_pk_bf16(v0[2], v0[3]); w.z = cvt_pk_bf16(v1[0], v1[1]); w.w = cvt_pk_bf16(v1[2], v1[3]);
                    *(u32x4*)(hp0 + (size_t)(ai * 128 + m * 16) * D + bj * 128) = w;
                    s += ((v0[0] * v0[0] + v0[1] * v0[1]) + (v0[2] * v0[2] + v0[3] * v0[3])) + ((v1[0] * v1[0] + v1[1] * v1[1]) + (v1[2] * v1[2] + v1[3] * v1[3]));
                }
                s += __shfl_xor(s, 16); s += __shfl_xor(s, 32);
                if (fq == 0) ex[lr * 4 + wc] = s;
            }
        __syncthreads();
        if (tid < 256) { const f32x4 e = *(const LAS f32x4*)(ex + tid * 4); ssout[(size_t)(brow + tid) * 4 + (bcol >> 8)] = (e[0] + e[1]) + (e[2] + e[3]); }
    }
    DEV void skinny(f32x4 a0, f32x4 a1, int mb, int pn, LAS unsigned char* lds) const {
        EPI_IDS
        const int row = TX + mb * 16 + fr, col = pn * 256 + wid * 32 + fq * 4;
        bf16_t* bp = hb + (size_t)row * D + col;
        const u32x2 r0 = *(const u32x2*)bp, r1 = *(const u32x2*)(bp + 16);
        f32x4 v0 = a0, v1 = a1;
        v0[0] += bflo(r0.x); v0[1] += bfhi(r0.x); v0[2] += bflo(r0.y); v0[3] += bfhi(r0.y);
        v1[0] += bflo(r1.x); v1[1] += bfhi(r1.x); v1[2] += bflo(r1.y); v1[3] += bfhi(r1.y);
        *(u32x2*)bp = (u32x2){cvt_pk_bf16(v0[0], v0[1]), cvt_pk_bf16(v0[2], v0[3])};
        *(u32x2*)(bp + 16) = (u32x2){cvt_pk_bf16(v1[0], v1[1]), cvt_pk_bf16(v1[2], v1[3])};
        float s = ((v0[0] * v0[0] + v0[1] * v0[1]) + (v0[2] * v0[2] + v0[3] * v0[3])) + ((v1[0] * v1[0] + v1[1] * v1[1]) + (v1[2] * v1[2] + v1[3] * v1[3]));
        s += __shfl_xor(s, 16); s += __shfl_xor(s, 32);
        LAS float* ex = (LAS float*)(lds + LDS_EX);
        if (fq == 0) ex[fr * 8 + wid] = s;
        __syncthreads();
        if (tid < 16) { const f32x4 e0 = *(const LAS f32x4*)(ex + tid * 8), e1 = *(const LAS f32x4*)(ex + tid * 8 + 4);
            ssout[(size_t)(TX + mb * 16 + tid) * 4 + pn] = ((e0[0] + e0[1]) + (e0[2] + e0[3])) + ((e1[0] + e1[1]) + (e1[2] + e1[3])); }
        __syncthreads();
    }
};

struct Epi3 {
    static constexpr bool PERM = false;
    bf16_t* act; const float* ss; unsigned* mcnt;
    DEV void prefetch(LAS unsigned char* lds, int brow, int par, int tid) const { if (tid < 256) GLDS(ss + (size_t)(brow + tid) * 4, lds + LDS_EX + par * 4096 + tid * 16); }
    DEV void operator()(f32x4 (&acc)[2][2][4][2], int brow, int bcol, LAS unsigned char* lds, int par) const {
        EPI_IDS
#pragma unroll
        for (int ai = 0; ai < 2; ++ai)
#pragma unroll
            for (int m = 0; m < 4; ++m) {
                const int lr = ai * 128 + wr * 64 + m * 16 + fr, row = brow + lr;
                const f32x4 s4 = *(const LAS f32x4*)(lds + LDS_EX + par * 4096 + lr * 16);
                const float rs = rsqrtf(((s4[0] + s4[1]) + (s4[2] + s4[3])) * (1.0f / 1024.0f) + EPS);
                float o[8];
                const float rs2 = rs * rs, ce = rs * -1.4426950408889634f;
#pragma unroll
                for (int bj = 0; bj < 2; ++bj) {
                    const f32x4 g = acc[ai][bj][m][0], u = acc[ai][bj][m][1];
#pragma unroll
                    for (int j = 0; j < 4; ++j) o[bj * 4 + j] = (g[j] * u[j]) * rs2 * __builtin_amdgcn_rcpf(1.0f + __builtin_amdgcn_exp2f(g[j] * ce));
                }
                *(u32x4*)(act + (size_t)row * DFF + (bcol >> 1) + wc * 32 + fq * 8) = pack8(o);
            }
    }
    DEV void skinny(f32x4 a0, f32x4 a1, int mb, int pn, LAS unsigned char*) const {
        EPI_IDS
        const int row = TX + mb * 16 + fr;
        const float rs = row_rs(ss, row);
        const f32x4 g = a0 * rs, u = a1 * rs;
        float o[4];
#pragma unroll
        for (int j = 0; j < 4; ++j) o[j] = g[j] * __builtin_amdgcn_rcpf(1.0f + __expf(-g[j])) * u[j];
        *(u32x2*)(act + (size_t)row * DFF + pn * 128 + (wid & 3) * 32 + fq * 8 + (wid >> 2) * 4) = (u32x2){cvt_pk_bf16(o[0], o[1]), cvt_pk_bf16(o[2], o[3])};
        asm volatile("s_waitcnt vmcnt(0)" ::: "memory");
        __syncthreads();
        if (tid == 0) { __builtin_amdgcn_fence(__ATOMIC_RELEASE, "agent"); asm volatile("s_waitcnt vmcnt(0)" ::: "memory"); (void)__hip_atomic_fetch_add(mcnt, 1u, __ATOMIC_RELAXED, __HIP_MEMORY_SCOPE_AGENT); }
    }
};

struct EpiF {
    static constexpr bool PERM = true;
    bf16_t* mix; int s, k1, L2;
    DEV void prefetch(LAS unsigned char*, int, int, int) const {}
    DEV void operator()(f32x4 (&acc)[2][2][4][2], int brow, int bcol, LAS unsigned char* lds, int) const {
        EPI_IDS
        LAS float* ex = (LAS float*)(lds + LDS_EX);
#pragma unroll
        for (int ai = 0; ai < 2; ++ai)
#pragma unroll
            for (int m = 0; m < 4; ++m) {
                const int lr = ai * 128 + wr * 64 + m * 16 + fr;
                float q = 0.f;
#pragma unroll
                for (int bj = 0; bj < 2; ++bj)
#pragma unroll
                    for (int n = 0; n < 2; ++n) { const f32x4 v = acc[ai][bj][m][n]; q += (v[0] * v[0] + v[1] * v[1]) + (v[2] * v[2] + v[3] * v[3]); }
                q += __shfl_xor(q, 16); q += __shfl_xor(q, 32);
                if (fq == 0) ex[lr * 4 + wc] = q;
            }
        __syncthreads();
#pragma unroll
        for (int ai = 0; ai < 2; ++ai)
#pragma unroll
            for (int m = 0; m < 4; ++m) {
                const int lr = ai * 128 + wr * 64 + m * 16 + fr, k2 = brow + lr;
                const f32x4 e = *(const LAS f32x4*)(ex + lr * 4);
                const float rs = rsqrtf(((e[0] + e[1]) + (e[2] + e[3])) * (1.0f / 256.0f) + EPS);
                if (k2 < L2) {
                    const int row = rowof(s, k1 + 16 * k2);
#pragma unroll
                    for (int bj = 0; bj < 2; ++bj) {
                        const f32x4 v0 = acc[ai][bj][m][0] * rs, v1 = acc[ai][bj][m][1] * rs;
                        u32x4 w; w.x = cvt_pk_bf16(v0[0], v0[1]); w.y = cvt_pk_bf16(v0[2], v0[3]); w.z = cvt_pk_bf16(v1[0], v1[1]); w.w = cvt_pk_bf16(v1[2], v1[3]);
                        *(u32x4*)(mix + (size_t)row * D + 768 + bj * 128 + wc * 32 + fq * 8) = w;
                    }
                }
            }
    }
    DEV void skinny(f32x4 a0, f32x4 a1, LAS unsigned char* lds) const {
        EPI_IDS
        float q = ((a0[0] * a0[0] + a0[1] * a0[1]) + (a0[2] * a0[2] + a0[3] * a0[3])) + ((a1[0] * a1[0] + a1[1] * a1[1]) + (a1[2] * a1[2] + a1[3] * a1[3]));
        q += __shfl_xor(q, 16); q += __shfl_xor(q, 32);
        LAS float* ex = (LAS float*)(lds + LDS_EX);
        if (fq == 0) ex[fr * 8 + wid] = q;
        __syncthreads();
        if (fr == 0) {
            const f32x4 e0 = *(const LAS f32x4*)ex, e1 = *(const LAS f32x4*)(ex + 4);
            const float rs = rsqrtf((((e0[0] + e0[1]) + (e0[2] + e0[3])) + ((e1[0] + e1[1]) + (e1[2] + e1[3]))) * (1.0f / 256.0f) + EPS);
            bf16_t* mp = mix + (size_t)rowof(s, k1 + 16 * (L2 - 1)) * D + 768 + wid * 32 + fq * 4;
            const f32x4 v0 = a0 * rs, v1 = a1 * rs;
            *(u32x2*)mp = (u32x2){cvt_pk_bf16(v0[0], v0[1]), cvt_pk_bf16(v0[2], v0[3])};
            *(u32x2*)(mp + 16) = (u32x2){cvt_pk_bf16(v1[0], v1[1]), cvt_pk_bf16(v1[2], v1[3])};
        }
        __syncthreads();
    }
};


DEV void phase_prologue(const Params& p, LAS unsigned char* lds) {
    unsigned char* ws = p.ws;
    int tid = threadIdx.x; asm volatile("" : "+v"(tid));
    const long gt = (long)blockIdx.x * NT + tid, gs = (long)gridDim.x * NT;
    LAS float* ctab = (LAS float*)lds;
    if (tid < 64) ctab[tid] = cospif((float)tid * (1.0f / 32.0f));
    __syncthreads();
    bf16_t* W1 = (bf16_t*)(ws + WS_W1); bf16_t* W2 = (bf16_t*)(ws + WS_W2); bf16_t* W3 = (bf16_t*)(ws + WS_W3); bf16_t* W4 = (bf16_t*)(ws + WS_W4);
    LAS unsigned char* xl = lds + 1024;
#define XPOSE_STORE4(pieces, dst0, ldk) do { _Pragma("unroll") for (int _q = 0; _q < 4; ++_q) *(LAS u32x4*)(xl + _q * 9216 + ((tid & 63) * 9 + (tid >> 6)) * 16) = (pieces)[_q]; __syncthreads(); \
        const int _r = tid >> 3, _c = tid & 7; _Pragma("unroll") for (int _q = 0; _q < 4; ++_q) { const u32x4 _v = *(const LAS u32x4*)(xl + _q * 9216 + (_r * 9 + _c) * 16); \
        *(u32x4*)((dst0) + (size_t)(_q * 64 + _r) * (ldk) + _c * 8) = _v; } __syncthreads(); } while (0)
    const int nl = tid & 63, k8l = tid >> 6;
    for (int S = blockIdx.x; S < DEPTH * 16 * 6; S += gridDim.x) {
        const int nq = S % 6, kb = (S / 6) % 16, l = S / (6 * 16), k0 = kb * 64 + k8l * 8;
        float v[4][8];
#pragma unroll
        for (int j = 0; j < 8; ++j) { const int k = k0 + j; const float g = p.norm1_g[l * D + k]; const float* src = p.w_in + ((size_t)l * D + k) * NIN0 + nq * 256 + nl;
#pragma unroll
            for (int q = 0; q < 4; ++q) v[q][j] = src[q * 64] * g; }
        u32x4 pc[4];
#pragma unroll
        for (int q = 0; q < 4; ++q) pc[q] = pack8(v[q]);
        XPOSE_STORE4(pc, W1 + ((size_t)l * NZ + nq * 256) * D + kb * 64, D);
    }
    for (int S = blockIdx.x; S < DEPTH * 16 * 4; S += gridDim.x) {
        const int nq = S % 4, kb = (S / 4) % 16, l = S / (4 * 16), k0 = kb * 64 + k8l * 8;
        float v[4][8];
#pragma unroll
        for (int j = 0; j < 8; ++j) { const int k = k0 + j; const float g = p.mix_g[l * D + k]; const float* src = p.w_out + ((size_t)l * D + k) * D + nq * 256 + nl;
#pragma unroll
            for (int q = 0; q < 4; ++q) v[q][j] = src[q * 64] * g; }
        u32x4 pc[4];
#pragma unroll
        for (int q = 0; q < 4; ++q) pc[q] = pack8(v[q]);
        XPOSE_STORE4(pc, W2 + ((size_t)l * D + nq * 256) * D + kb * 64, D);
    }
    for (int S = blockIdx.x; S < DEPTH * 16 * 22; S += gridDim.x) {
        const int pn = S % 22, kb = (S / 22) % 16, l = S / (22 * 16), k0 = kb * 64 + k8l * 8;
        int col[4];
#pragma unroll
        for (int q = 0; q < 4; ++q) { const int rem = q * 64 + nl, bj = rem >> 7, wc = (rem >> 5) & 3, nn = (rem >> 4) & 1, i = rem & 15;
            const int d = pn * 128 + wc * 32 + (i >> 2) * 8 + bj * 4 + (i & 3); col[q] = nn ? DFF + d : d; }
        float v[4][8];
#pragma unroll
        for (int j = 0; j < 8; ++j) { const int k = k0 + j; const float g = p.norm2_g[l * D + k]; const float* src = p.w_gate_up + ((size_t)l * D + k) * NGU;
#pragma unroll
            for (int q = 0; q < 4; ++q) v[q][j] = src[col[q]] * g; }
        u32x4 pc[4];
#pragma unroll
        for (int q = 0; q < 4; ++q) pc[q] = pack8(v[q]);
        XPOSE_STORE4(pc, W3 + ((size_t)l * NGU + pn * 256) * D + kb * 64, D);
    }
    for (int S = blockIdx.x; S < DEPTH * 44 * 4; S += gridDim.x) {
        const int nq = S % 4, kb = (S / 4) % 44, l = S / (4 * 44), k0 = kb * 64 + k8l * 8;
        float v[4][8];
#pragma unroll
        for (int j = 0; j < 8; ++j) { const int k = k0 + j; const float* src = p.w_down + ((size_t)l * DFF + k) * D + nq * 256 + nl;
#pragma unroll
            for (int q = 0; q < 4; ++q) v[q][j] = src[q * 64]; }
        u32x4 pc[4];
#pragma unroll
        for (int q = 0; q < 4; ++q) pc[q] = pack8(v[q]);
        XPOSE_STORE4(pc, W4 + ((size_t)l * D + nq * 256) * DFF + kb * 64, DFF);
    }
#undef XPOSE_STORE4
    {
        float tt[64];
#pragma unroll
        for (int c = 0; c < 64; ++c) { const int jj = ((nl < 33 ? nl : nl - 32) * c) & 63; tt[c] = nl < 33 ? ctab[jj] : -ctab[(jj - 16) & 63]; }
        LAS float* sb = (LAS float*)(lds + 40960);
        for (int S = blockIdx.x; S < DEPTH * 16 * 4; S += gridDim.x) {
            const int hd = S % 4, kb = (S / 4) % 16, l = S / (4 * 16);
#pragma unroll
            for (int j = 0; j < 2; ++j) { const int k = (tid >> 4) + 32 * j, c4 = (tid & 15) * 4;
                *(LAS f32x4*)(sb + k * 64 + c4) = *(const f32x4*)(p.w_in + ((size_t)l * D + kb * 64 + k) * NIN0 + 1536 + hd * 64 + c4); }
            __syncthreads();
            float val[8];
#pragma unroll
            for (int j = 0; j < 8; ++j) {
                const int k = k8l * 8 + j;
                float a = 0.f;
#pragma unroll
                for (int c4 = 0; c4 < 64; c4 += 4) { const f32x4 x = *(const LAS f32x4*)(sb + k * 64 + c4);
#pragma unroll
                    for (int e = 0; e < 4; ++e) a += x[e] * tt[c4 + e]; }
                val[j] = a * p.norm1_g[l * D + kb * 64 + k];
            }
            *(LAS u32x4*)(xl + ((tid & 63) * 9 + (tid >> 6)) * 16) = pack8(val);
            __syncthreads();
            { const int r = tid >> 3, c = tid & 7;
              *(u32x4*)(W1 + ((size_t)l * NZ + 1536 + hd * 64 + r) * D + kb * 64 + c * 8) = *(const LAS u32x4*)(xl + (r * 9 + c) * 16); }
            __syncthreads();
        }
    }
    bf16_t* PW = (bf16_t*)(ws + WS_PW);
    for (long i = gt; i < (long)DEPTH * 4 * 96 * 96; i += gs) {
        const int k = (int)(i % 96), n = (int)((i / 96) % 96), lg = (int)(i / (96 * 96)), l = lg >> 2, g = lg & 3;
        const float v = p.pool_w[((size_t)lg * 96 + k) * 96 + n] * p.pool_scale[l * 384 + g * 96 + n];
        PW[i] = (bf16_t)(cvt_pk_bf16(v, 0.f) & 0xffff);
    }
    bf16_t* DPm = (bf16_t*)(ws + WS_DP); bf16_t* DSm = (bf16_t*)(ws + WS_DS);
    for (long i = gt; i < (long)MPP * KP; i += gs) {
        const int kk = (int)(i % KP), k2 = (int)(i / KP), part = kk / KHP, n2 = kk % KHP;
        float v = 0.f;
        if (k2 < L2P && n2 < L2P) { const float a = (float)(2 * ((k2 * n2) % L2P)) * (1.0f / (float)L2P); v = part == 0 ? cospif(a) : sinpif(a); }
        DPm[i] = (bf16_t)(cvt_pk_bf16(v, 0.f) & 0xffff);
    }
    for (long i = gt; i < (long)MPS * KS; i += gs) {
        const int kk = (int)(i % KS), k2 = (int)(i / KS), part = kk / KHS, n2 = kk % KHS;
        float v = 0.f;
        if (k2 < L2S && n2 < L2S) { const float a = (float)(2 * ((k2 * n2) % L2S)) * (1.0f / (float)L2S); v = part == 0 ? cospif(a) : sinpif(a); }
        DSm[i] = (bf16_t)(cvt_pk_bf16(v, 0.f) & 0xffff);
    }
    f32x2* TWPt = (f32x2*)(ws + WS_TWP); f32x2* TWSt = (f32x2*)(ws + WS_TWS);
    for (long i = gt; i < 16 * KHP; i += gs) {
        const int n2 = (int)(i % KHP), k1 = (int)(i / KHP);
        const float a = (float)(2 * ((k1 * n2) % LP)) * (1.0f / (float)LP), sc = 1.0f / sqrtf(64.0f * (float)LP);
        TWPt[i] = (f32x2){cospif(a) * sc, -sinpif(a) * sc};
    }
    for (long i = gt; i < 16 * KHS; i += gs) {
        const int n2 = (int)(i % KHS), k1 = (int)(i / KHS);
        const float a = (float)(2 * ((k1 * n2) % LS)) * (1.0f / (float)LS), sc = 1.0f / sqrtf(64.0f * (float)LS);
        TWSt[i] = (f32x2){cospif(a) * sc, -sinpif(a) * sc};
    }
    bf16_t* hb = (bf16_t*)(ws + WS_HB); float* ss1 = (float*)(ws + WS_SS1);
    const int lane = tid & 63, gw = (int)(gt >> 6), nw = (int)(gs >> 6);
    for (int r0 = gw * 4; r0 < T; r0 += nw * 4) {
        f32x4 v[4][4];
#pragma unroll
        for (int q = 0; q < 4; ++q) {
            const int r = r0 + q;
            const float* src = r < 16384 ? p.x_prompt + (size_t)r * D : (r < TX ? p.x_sample + (size_t)(r - 16384) * D : p.meta + (size_t)((r - TX) & 15) * D);
#pragma unroll
            for (int j = 0; j < 4; ++j) v[q][j] = __builtin_nontemporal_load((const f32x4*)(src + j * 256 + lane * 4));
        }
        float s[4];
#pragma unroll
        for (int q = 0; q < 4; ++q) {
            s[q] = 0.f;
#pragma unroll
            for (int j = 0; j < 4; ++j) {
                const f32x4 x = v[q][j];
                u32x2 w; w.x = cvt_pk_bf16(x[0], x[1]); w.y = cvt_pk_bf16(x[2], x[3]);
                *(u32x2*)(hb + (size_t)(r0 + q) * D + j * 256 + lane * 4) = w;
                s[q] += (x[0] * x[0] + x[1] * x[1]) + (x[2] * x[2] + x[3] * x[3]);
            }
        }
#pragma unroll
        for (int o = 32; o >= 1; o >>= 1)
#pragma unroll
            for (int q = 0; q < 4; ++q) s[q] += __shfl_xor(s[q], o);
        if (lane < 4) { const float sv = lane == 0 ? s[0] : (lane == 1 ? s[1] : (lane == 2 ? s[2] : s[3])); *(f32x4*)(ss1 + (size_t)(r0 + lane) * 4) = (f32x4){sv, 0.f, 0.f, 0.f}; }
    }
}

DEV void phase_xb(const Params& p, int it0, int itstep);
DEV void phase_gemm1(const Params& p, int l, LAS unsigned char* lds) {
    unsigned char* ws = p.ws;
    unsigned* vcnt = (unsigned*)(ws + WS_BAR) + VCNT_WORD0 + 64 * l;
    Epi1 e{(bf16_t*)(ws + WS_Z), (const float*)(ws + WS_SS1), vcnt};
    const bf16_t* A = (const bf16_t*)(ws + WS_HB); const bf16_t* B = (const bf16_t*)(ws + WS_W1) + (size_t)l * NZ * D;
    const int G = gridDim.x, b = blockIdx.x;
    const bool tail = (G == 256) ? (b >= 64) : true;
    if (G == 256) { if (b < 63) skinny_item(lds, A, D, B, D, D, b % 9, 6 - b / 9, e); }
    else for (int i = b; i < 9 * 7; i += G) skinny_item(lds, A, D, B, D, D, i % 9, 6 - i / 9, e);
    gemm_loop<0>(lds, A, D, B, D, D, e, b, G, 192 * 7, TileG1{});
    if (tail) {
        int tid = threadIdx.x; asm volatile("" : "+v"(tid));
        if (tid == 0) { unsigned sp = 0; while (__hip_atomic_load(vcnt, __ATOMIC_RELAXED, __HIP_MEMORY_SCOPE_AGENT) < (unsigned)NVTILES) { __builtin_amdgcn_s_sleep(1); if (++sp > (1u << 22)) break; } }
        __syncthreads();
        __builtin_amdgcn_fence(__ATOMIC_ACQUIRE, "agent");
        asm volatile("s_waitcnt vmcnt(0)" ::: "memory");
        if (G == 256) phase_xb(p, b - 64, 192); else phase_xb(p, b, G);
    }
}
DEV void phase_gemm2(const Params& p, int l, LAS unsigned char* lds) {
    unsigned char* ws = p.ws;
    EpiRes e{(bf16_t*)(ws + WS_HB), (float*)(ws + WS_SS2)};
    const bf16_t* A = (const bf16_t*)(ws + WS_MIX); const bf16_t* B = (const bf16_t*)(ws + WS_W2) + (size_t)l * D * D;
    if (l < DEPTH - 1) for (int i = blockIdx.x; i < 9 * 4; i += gridDim.x) skinny_item(lds, A, D, B, D, D, i % 9, i / 9, e);
    gemm_loop<0>(lds, A, D, B, D, D, e, blockIdx.x, gridDim.x, 192 * 4, TileMap{192, 4});
}
DEV void phase_gemm3(const Params& p, int l, LAS unsigned char* lds) {
    unsigned char* ws = p.ws;
    unsigned* mcnt = (unsigned*)(ws + WS_BAR) + MCNT_WORD0 + 64 * l;
    Epi3 e{(bf16_t*)(ws + WS_ACT), (const float*)(ws + WS_SS2), mcnt};
    const bf16_t* A = (const bf16_t*)(ws + WS_HB); const bf16_t* B = (const bf16_t*)(ws + WS_W3) + (size_t)l * NGU * D;
    const int G = gridDim.x, b = blockIdx.x;
    if (l == DEPTH - 1) {}
    else if (G == 256) { if (b >= 128) for (int i = b - 128; i < 9 * 22; i += 128) skinny_item(lds, A, D, B, D, D, i % 9, i / 9, e); }
    else for (int i = b; i < 9 * 22; i += G) skinny_item(lds, A, D, B, D, D, i % 9, i / 9, e);
    gemm_loop<0>(lds, A, D, B, D, D, e, b, G, 192 * 22, TileMap{192, 22});
    if (l < DEPTH - 1 && G == 256 && b >= 220) {
        int tid = threadIdx.x; asm volatile("" : "+v"(tid));
        if (tid == 0) { unsigned sp = 0; while (__hip_atomic_load(mcnt, __ATOMIC_RELAXED, __HIP_MEMORY_SCOPE_AGENT) < 198u) { __builtin_amdgcn_s_sleep(1); if (++sp > (1u << 22)) break; } }
        __syncthreads();
        __builtin_amdgcn_fence(__ATOMIC_ACQUIRE, "agent");
        asm volatile("s_waitcnt vmcnt(0)" ::: "memory");
        EpiRes e4{(bf16_t*)(ws + WS_HB), (float*)(ws + WS_SS1)};
        const int i = b - 220;
        skinny_item(lds, (const bf16_t*)(ws + WS_ACT), DFF, (const bf16_t*)(ws + WS_W4) + (size_t)l * D * DFF, DFF, DFF, i % 9, i / 9, e4);
    }
}
DEV void phase_gemm4(const Params& p, int l, LAS unsigned char* lds) {
    unsigned char* ws = p.ws;
    EpiRes e{(bf16_t*)(ws + WS_HB), (float*)(ws + WS_SS1)};
    const bf16_t* A = (const bf16_t*)(ws + WS_ACT); const bf16_t* B = (const bf16_t*)(ws + WS_W4) + (size_t)l * D * DFF;
    if (l < DEPTH - 1 && gridDim.x != 256) for (int i = blockIdx.x; i < 9 * 4; i += gridDim.x) skinny_item(lds, A, DFF, B, DFF, DFF, i % 9, i / 9, e);
    gemm_loop<0>(lds, A, DFF, B, DFF, DFF, e, blockIdx.x, gridDim.x, 192 * 4, TileMapRev{192, 4});
}
DEV void dft_item(const Params& p, int it, LAS unsigned char* lds) {
    unsigned char* ws = p.ws;
    bf16_t* mix = (bf16_t*)(ws + WS_MIX);
    const bf16_t* wbp = (const bf16_t*)((unsigned char*)p.out + OUT_WBP); const bf16_t* wbs = (const bf16_t*)((unsigned char*)p.out + OUT_WBS);
    if (it < 64) {
        const int pm = it & 3, pn = it >> 2;
        EpiF e{mix, 0, pn, L2P};
        gemm_loop<1>(lds, (const bf16_t*)(ws + WS_DP), KP, wbp, NCP, KP, e, 0, 1, 1, TileOne{pm * 256, pn * 256});
    } else if (it < 192) {
        const int pn = it - 64;
        EpiF e{mix, 1 + (pn >> 4), pn & 15, L2S};
        gemm_loop<1>(lds, (const bf16_t*)(ws + WS_DS), KS, wbs, NCS, KS, e, 0, 1, 1, TileOne{0, pn * 256});
    } else if (it < 208) {
        const int pn = it - 192;
        EpiF e{mix, 0, pn, L2P};
        skinny_dft(lds, (const bf16_t*)(ws + WS_DP), KP, wbp, NCP, KP, L2P - 1, pn * 256, e);
    } else {
        const int pn = it - 208;
        EpiF e{mix, 1 + (pn >> 4), pn & 15, L2S};
        skinny_dft(lds, (const bf16_t*)(ws + WS_DS), KS, wbs, NCS, KS, L2S - 1, pn * 256, e);
    }
}
DEV void phase_dft(const Params& p, LAS unsigned char* lds) {
    const int b = blockIdx.x, G = gridDim.x;
    if (G == 256) {
        if (b < 192) dft_item(p, b, lds);
        else for (int it = b; it < 336; it += 64) dft_item(p, it, lds);
    } else {
        for (int it = b; it < 336; it += G) dft_item(p, it, lds);
    }
}

struct XaTile { int s, p0, np, L; };
DEV XaTile xa_next(int& g0, int g1) {
    XaTile t; t.s = 0; t.p0 = 0; t.np = 0; t.L = 16;
    if (g0 < g1) {
        int gs, gl;
        if (g0 < 1025) { t.s = 0; gs = 0; gl = 1025; } else { const int q = (g0 - 1025) / 257; t.s = 1 + q; gs = 1025 + 257 * q; gl = 257; }
        const int ng = min(4, min(g1, gs + gl) - g0);
        t.p0 = (g0 - gs) * 16; t.np = ng * 16; t.L = gl * 16; g0 += ng;
    }
    return t;
}
DEV void xa_stage_load(const bf16_t* z, const XaTile& t, int tid, u32x4 (&v)[8]) {
    const int nchunk = (t.np + 15) * 48;
#pragma unroll
    for (int j = 0; j < 8; ++j) {
        const int c = tid + j * NT, i = c / 48, cg8 = c % 48, pp = t.p0 - 8 + i;
        v[j] = (u32x4){0u, 0u, 0u, 0u};
        if (t.np > 0 && c < nchunk && pp >= 0 && pp < t.L) v[j] = *(const u32x4*)(z + (size_t)rowof(t.s, pp) * NZ + 1152 + cg8 * 8);
    }
}
struct ConvRegs { u32x4 xa[6], gc[6], gb[4]; };
DEV void xa_conv_load(const bf16_t* z, const XaTile& t, int tb, int lane, ConvRegs& r, int (&rows)[6]) {
#pragma unroll
    for (int i = 0; i < 6; ++i) { const int pp = t.p0 + tb - 1 + i; rows[i] = rowof(t.s, min(max(pp, 0), t.L - 1)); }
    if (tb < t.np && lane < 48) {
        const int c = lane * 8;
#pragma unroll
        for (int i = 0; i < 6; ++i) { const bf16_t* q = z + (size_t)rows[i] * NZ + c; r.xa[i] = *(const u32x4*)q; r.gc[i] = *(const u32x4*)(q + 768); }
#pragma unroll
        for (int k = 0; k < 4; ++k) r.gb[k] = *(const u32x4*)(z + (size_t)rows[k + 1] * NZ + c + 384);
    }
}
DEV void xa_conv_finish(bf16_t* mix, const float* cw, const XaTile& t, int tb, int lane, const ConvRegs& r, const int (&rows)[6]) {
    if (tb >= t.np) return;
    float a[4][8]; float sq[4] = {0.f, 0.f, 0.f, 0.f};
    if (lane < 48) {
        const int c = lane * 8;
        float wv[3][8];
#pragma unroll
        for (int q = 0; q < 3; ++q) { const f32x4 w0 = *(const f32x4*)(cw + q * 384 + c), w1 = *(const f32x4*)(cw + q * 384 + c + 4);
#pragma unroll
            for (int j = 0; j < 4; ++j) { wv[q][j] = w0[j]; wv[q][4 + j] = w1[j]; } }
        float y[6][8];
#pragma unroll
        for (int i = 0; i < 6; ++i) {
            const int pp = t.p0 + tb - 1 + i;
            const float msk = (pp >= 0 && pp < t.L) ? 1.0f : 0.0f;
#pragma unroll
            for (int j = 0; j < 4; ++j) { y[i][2 * j] = bflo(r.xa[i][j]) * bflo(r.gc[i][j]) * msk; y[i][2 * j + 1] = bfhi(r.xa[i][j]) * bfhi(r.gc[i][j]) * msk; }
        }
#pragma unroll
        for (int k = 0; k < 4; ++k)
#pragma unroll
            for (int j = 0; j < 4; ++j) {
                const int e0 = 2 * j, e1 = 2 * j + 1;
                a[k][e0] = bflo(r.gb[k][j]) * (wv[0][e0] * y[k][e0] + wv[1][e0] * y[k + 1][e0] + wv[2][e0] * y[k + 2][e0]);
                a[k][e1] = bfhi(r.gb[k][j]) * (wv[0][e1] * y[k][e1] + wv[1][e1] * y[k + 1][e1] + wv[2][e1] * y[k + 2][e1]);
                sq[k] += a[k][e0] * a[k][e0] + a[k][e1] * a[k][e1];
            }
    } else {
#pragma unroll
        for (int k = 0; k < 4; ++k)
#pragma unroll
            for (int j = 0; j < 8; ++j) a[k][j] = 0.f;
    }
#pragma unroll
    for (int o = 32; o >= 1; o >>= 1)
#pragma unroll
        for (int k = 0; k < 4; ++k) sq[k] += __shfl_xor(sq[k], o);
    if (lane < 48) {
#pragma unroll
        for (int k = 0; k < 4; ++k) {
            const float rs = rsqrtf(sq[k] * (1.0f / 384.0f) + EPS);
#pragma unroll
            for (int j = 0; j < 8; ++j) a[k][j] *= rs;
            *(u32x4*)(mix + (size_t)rows[k + 1] * D + lane * 8) = pack8(a[k]);
        }
    }
}
DEV void lds_row_add(const LAS bf16_t* q, float (&S)[8], float sign) {
    const u32x4 v = *(const LAS u32x4*)q;
#pragma unroll
    for (int j = 0; j < 4; ++j) { S[2 * j] += sign * bflo(v[j]); S[2 * j + 1] += sign * bfhi(v[j]); }
}
#define XA_BAR do { asm volatile("s_waitcnt lgkmcnt(0)" ::: "memory"); __builtin_amdgcn_s_barrier(); } while (0)

DEV void xa_tile(const Params& p, int l, const XaTile& t, const XaTile& tn, u32x4 (&st)[8], LAS unsigned char* lds, const bf16x8 (&bfr)[3][3]) {
    unsigned char* ws = p.ws;
    const bf16_t* z = (const bf16_t*)(ws + WS_Z); bf16_t* mix = (bf16_t*)(ws + WS_MIX);
    const float* cw = p.conv_w + (size_t)l * 3 * 384;
    int tid = threadIdx.x; asm volatile("" : "+v"(tid));
    const int wid = tid >> 6, lane = tid & 63, fr = lane & 15, fq = lane >> 4;
    LAS bf16_t* xs = (LAS bf16_t*)lds;
    LAS bf16_t* pre = (LAS bf16_t*)(lds + 80 * 784);
    LAS float* psum = (LAS float*)(lds + 80 * 784 + 64 * 784);
    const int np = t.np, p0 = t.p0, L = t.L, nchunk = (np + 15) * 48;
    ConvRegs cr; int rows[6];
    xa_conv_load(z, t, wid * 8, lane, cr, rows);
#pragma unroll
    for (int j = 0; j < 8; ++j) { const int c = tid + j * NT, i = c / 48, cg8 = c % 48; if (c < nchunk) *(LAS u32x4*)(xs + i * 392 + cg8 * 8) = st[j]; }
    xa_stage_load(z, tn, tid, st);
    XA_BAR;
    if (tid < 384) {
        const int cg8 = tid % 48, seg = tid / 48, gi = cg8 / 12, left = 1 << gi, right = left - 1, t0 = seg * 8;
        if (t0 < np) {
            const LAS bf16_t* col = xs + cg8 * 8;
            float S[8];
#pragma unroll
            for (int j = 0; j < 8; ++j) S[j] = 0.f;
            for (int q = t0 + 8 - left; q <= t0 + 8 + right; ++q) lds_row_add(col + q * 392, S, 1.0f);
#pragma unroll
            for (int k = 0; k < 8; ++k) {
                const int tt = t0 + k, i = tt + 8, pp = p0 + tt;
                const float inv = 1.0f / (float)(min(pp + right, L - 1) - max(pp - left, 0) + 1);
                float o[8];
#pragma unroll
                for (int j = 0; j < 8; ++j) o[j] = S[j] * inv;
                lds_row_add(col + i * 392, o, -1.0f);
                *(LAS u32x4*)(pre + tt * 392 + cg8 * 8) = pack8(o);
                if (k < 7) { lds_row_add(col + (i + right + 1) * 392, S, 1.0f); lds_row_add(col + (i - left) * 392, S, -1.0f); }
            }
        }
    }
    xa_conv_finish(mix, cw, t, wid * 8, lane, cr, rows);
    xa_conv_load(z, t, wid * 8 + 4, lane, cr, rows);
    XA_BAR;
    const int g = wid >> 1, nbh = wid & 1, nmb = np >> 4;
    f32x4 pacc[4][3];
#pragma unroll
    for (int mb = 0; mb < 4; ++mb)
#pragma unroll
        for (int nb = 0; nb < 3; ++nb) pacc[mb][nb] = (f32x4){0.f, 0.f, 0.f, 0.f};
#pragma unroll
    for (int mb = 0; mb < 4; ++mb) {
        if (mb < nmb) {
#pragma unroll
            for (int ks = 0; ks < 3; ++ks) {
                const bf16x8 af = *(const LAS bf16x8*)(pre + (mb * 16 + fr) * 392 + g * 96 + ks * 32 + fq * 8);
#pragma unroll
                for (int nb = 0; nb < 3; ++nb) pacc[mb][nb] = __builtin_amdgcn_mfma_f32_16x16x32_bf16(bfr[nb][ks], af, pacc[mb][nb], 0, 0, 0);
            }
            float q = 0.f;
#pragma unroll
            for (int nb = 0; nb < 3; ++nb) { const f32x4 v = pacc[mb][nb]; q += (v[0] * v[0] + v[1] * v[1]) + (v[2] * v[2] + v[3] * v[3]); }
            q += __shfl_xor(q, 16); q += __shfl_xor(q, 32);
            if (fq == 0) psum[(mb * 16 + fr) * 8 + wid] = q;
        }
    }
    XA_BAR;
#pragma unroll
    for (int mb = 0; mb < 4; ++mb) {
        if (mb < nmb) {
            const f32x4 e0 = *(const LAS f32x4*)(psum + (mb * 16 + fr) * 8), e1 = *(const LAS f32x4*)(psum + (mb * 16 + fr) * 8 + 4);
            const float rs = rsqrtf((((e0[0] + e0[1]) + (e0[2] + e0[3])) + ((e1[0] + e1[1]) + (e1[2] + e1[3]))) * (1.0f / 384.0f) + EPS);
            const int row = rowof(t.s, p0 + mb * 16 + fr);
#pragma unroll
            for (int nb = 0; nb < 3; ++nb) {
                const f32x4 v = pacc[mb][nb] * rs;
                u32x2 w; w.x = cvt_pk_bf16(v[0], v[1]); w.y = cvt_pk_bf16(v[2], v[3]);
                *(u32x2*)(mix + (size_t)row * D + 384 + g * 96 + (nbh * 3 + nb) * 16 + fq * 4) = w;
            }
        }
    }
    xa_conv_finish(mix, cw, t, wid * 8 + 4, lane, cr, rows);
    XA_BAR;
}

DEV void phase_xa(const Params& p, int l, LAS unsigned char* lds) {
    int g0, g1;
    if (gridDim.x == 256) {
        const int b = blockIdx.x, b1 = b + 1;
        const int c0 = b < 64 ? 60 * b : (b < 192 ? 3840 + 140 * (b - 64) : 21760 + 143 * (b - 192));
        const int c1 = b1 < 64 ? 60 * b1 : (b1 < 192 ? 3840 + 140 * (b1 - 64) : 21760 + 143 * (b1 - 192));
        g0 = (int)((long)c0 * NGROUPS / 30912); g1 = (int)((long)c1 * NGROUPS / 30912);
    } else { g0 = (int)((long)blockIdx.x * NGROUPS / gridDim.x); g1 = (int)((long)(blockIdx.x + 1) * NGROUPS / gridDim.x); }
    int tid = threadIdx.x; asm volatile("" : "+v"(tid));
    bf16x8 bfr[3][3];
    {
        const int wid = tid >> 6, lane = tid & 63, fr = lane & 15, fq = lane >> 4, g = wid >> 1, nbh = wid & 1;
        const bf16_t* pw = (const bf16_t*)(p.ws + WS_PW) + (size_t)l * 4 * 96 * 96;
#pragma unroll
        for (int nb = 0; nb < 3; ++nb)
#pragma unroll
            for (int ks = 0; ks < 3; ++ks) bfr[nb][ks] = *(const bf16x8*)(pw + ((size_t)g * 96 + (nbh * 3 + nb) * 16 + fr) * 96 + ks * 32 + fq * 8);
    }
    const bf16_t* z = (const bf16_t*)(p.ws + WS_Z);
    XaTile t = xa_next(g0, g1);
    u32x4 st[8];
    xa_stage_load(z, t, tid, st);
    while (t.np > 0) {
        const XaTile tn = xa_next(g0, g1);
        xa_tile(p, l, t, tn, st, lds, bfr);
        t = tn;
    }
    asm volatile("s_waitcnt vmcnt(0)" ::: "memory");
    __syncthreads();
}

DEV void dft4(float& ar, float& ai, float& br, float& bi, float& cr, float& ci, float& dr, float& di) {
    const float s0r = ar + cr, s0i = ai + ci, d0r = ar - cr, d0i = ai - ci;
    const float s1r = br + dr, s1i = bi + di, d1r = br - dr, d1i = bi - di;
    ar = s0r + s1r; ai = s0i + s1i; cr = s0r - s1r; ci = s0i - s1i;
    br = d0r + d1i; bi = d0i - d1r; dr = d0r - d1i; di = d0i + d1r;
}
DEV void cmulc(float& r, float& i, float c, float s) { const float tr = r * c - i * s, ti = r * s + i * c; r = tr; i = ti; }

DEV void phase_xb(const Params& p, int it0, int itstep) {
    unsigned char* ws = p.ws;
    const bf16_t* z = (const bf16_t*)(ws + WS_Z);
    int tid = threadIdx.x; asm volatile("" : "+v"(tid));
    const int m = tid & 255, half = tid >> 8;
    const int hdc = 1536 + (m >> 6) * 64, ml = m & 63;
    const int cre = hdc + (ml <= 32 ? ml : 64 - ml);
    const int cim = hdc + 32 + ((ml & 31) == 0 ? 1 : (ml < 32 ? ml : 64 - ml));
    const float sgn = (ml & 31) == 0 ? 0.f : (ml < 32 ? 1.f : -1.f);
    for (int it = it0; it < 136 + 8 * 40; it += itstep) {
        int s, gq, L2, KH, N, colbase; const f32x2* tw; bf16_t* wb;
        if (it < 136) { s = 0; gq = it; L2 = L2P; KH = KHP; N = NCP; colbase = 0; tw = (const f32x2*)(ws + WS_TWP); wb = (bf16_t*)((unsigned char*)p.out + OUT_WBP); }
        else { const int j = it - 136; s = 1 + j / 40; gq = j % 40; L2 = L2S; KH = KHS; N = NCS; colbase = (s - 1) * 4096; tw = (const f32x2*)(ws + WS_TWS); wb = (bf16_t*)((unsigned char*)p.out + OUT_WBS); }
        unsigned outr[16][2], outi[16][2];
        bf16_t raw[2][32];
#define XB_LOAD(set, idx) do { const int _n2 = 8 * gq + 4 * half + (idx); \
            if (_n2 < L2) { _Pragma("unroll") for (int n1 = 0; n1 < 16; ++n1) { const bf16_t* q = z + (size_t)rowof(s, L2 * n1 + _n2) * NZ; raw[set][2 * n1] = q[cre]; raw[set][2 * n1 + 1] = q[cim]; } } \
            else { _Pragma("unroll") for (int n1 = 0; n1 < 32; ++n1) raw[set][n1] = 0; } } while (0)
        XB_LOAD(0, 0);
        float pr[2][16], pi[2][16];
#pragma unroll
        for (int idx = 0; idx < 4; ++idx) {
            const int i2 = idx >> 1, i1 = idx & 1, set = idx & 1;
            if (idx < 3) XB_LOAD(set ^ 1, idx + 1);
            SCHED;
            {
                const int n2 = 8 * gq + 4 * half + idx;
                float xr[16], xi[16];
                if (n2 < L2) {
#pragma unroll
                    for (int n1 = 0; n1 < 16; ++n1) { xr[n1] = bf2f(raw[set][2 * n1]); xi[n1] = bf2f(raw[set][2 * n1 + 1]) * sgn; }
#pragma unroll
                    for (int b = 0; b < 4; ++b) dft4(xr[b], xi[b], xr[4 + b], xi[4 + b], xr[8 + b], xi[8 + b], xr[12 + b], xi[12 + b]);
                    const float C1 = 0.92387953251128674f, S1 = 0.38268343236508977f, R2 = 0.70710678118654752f;
                    cmulc(xr[5], xi[5], C1, -S1);
                    cmulc(xr[6], xi[6], R2, -R2);
                    cmulc(xr[7], xi[7], S1, -C1);
                    cmulc(xr[9], xi[9], R2, -R2);
                    cmulc(xr[10], xi[10], 0.f, -1.f);
                    cmulc(xr[11], xi[11], -R2, -R2);
                    cmulc(xr[13], xi[13], S1, -C1);
                    cmulc(xr[14], xi[14], -R2, -R2);
                    cmulc(xr[15], xi[15], -C1, S1);
#pragma unroll
                    for (int c = 0; c < 4; ++c) dft4(xr[4 * c], xi[4 * c], xr[4 * c + 1], xi[4 * c + 1], xr[4 * c + 2], xi[4 * c + 2], xr[4 * c + 3], xi[4 * c + 3]);
#pragma unroll
                    for (int c = 0; c < 4; ++c)
#pragma unroll
                        for (int d = 0; d < 4; ++d) {
                            const int k1 = c + 4 * d;
                            const f32x2 t2 = tw[k1 * KH + n2];
                            const float r = xr[4 * c + d], i = xi[4 * c + d];
                            pr[i1][k1] = r * t2[0] - i * t2[1]; pi[i1][k1] = r * t2[1] + i * t2[0];
                        }
                } else {
#pragma unroll
                    for (int k1 = 0; k1 < 16; ++k1) { pr[i1][k1] = 0.f; pi[i1][k1] = 0.f; }
                }
            }
            if (i1 == 1) {
#pragma unroll
                for (int k1 = 0; k1 < 16; ++k1) { outr[k1][i2] = cvt_pk_bf16(pr[0][k1], pr[1][k1]); outi[k1][i2] = cvt_pk_bf16(pi[0][k1], pi[1][k1]); }
            }
        }
#undef XB_LOAD
#pragma unroll
        for (int k1 = 0; k1 < 16; ++k1) {
            const size_t col = (size_t)colbase + k1 * 256 + m;
            *(u32x2*)(wb + ((size_t)gq * N + col) * 8 + half * 4) = (u32x2){outr[k1][0], outr[k1][1]};
            *(u32x2*)(wb + ((size_t)(KH / 8 + gq) * N + col) * 8 + half * 4) = (u32x2){outi[k1][0], outi[k1][1]};
        }
    }
}

DEV void phase_final(const Params& p) {
    const float* ss = (const float*)(p.ws + WS_SS1);
    const bf16_t* hb = (const bf16_t*)(p.ws + WS_HB);
    int tid = threadIdx.x; asm volatile("" : "+v"(tid));
    const int lane = tid & 63;
    const int gw = (int)(((long)blockIdx.x * NT + tid) >> 6), nw = (int)(((long)gridDim.x * NT) >> 6);
    const f32x4 g00 = *(const f32x4*)(p.final_g + lane * 8), g01 = *(const f32x4*)(p.final_g + lane * 8 + 4);
    const f32x4 g10 = *(const f32x4*)(p.final_g + 512 + lane * 8), g11 = *(const f32x4*)(p.final_g + 512 + lane * 8 + 4);
    for (int r0 = gw * 2; r0 < TX; r0 += nw * 2) {
        u32x4 h[2][2]; float rs[2];
#pragma unroll
        for (int q = 0; q < 2; ++q) {
            rs[q] = row_rs(ss, r0 + q);
#pragma unroll
            for (int j = 0; j < 2; ++j) h[q][j] = __builtin_nontemporal_load((const u32x4*)(hb + (size_t)(r0 + q) * D + j * 512 + lane * 8));
        }
#pragma unroll
        for (int q = 0; q < 2; ++q) {
            float* o = p.out + (size_t)(r0 + q) * D + lane * 8;
            const float s0 = rs[q];
            __builtin_nontemporal_store((f32x4){bflo(h[q][0].x) * s0 * g00[0], bfhi(h[q][0].x) * s0 * g00[1], bflo(h[q][0].y) * s0 * g00[2], bfhi(h[q][0].y) * s0 * g00[3]}, (f32x4*)(o));
            __builtin_nontemporal_store((f32x4){bflo(h[q][0].z) * s0 * g01[0], bfhi(h[q][0].z) * s0 * g01[1], bflo(h[q][0].w) * s0 * g01[2], bfhi(h[q][0].w) * s0 * g01[3]}, (f32x4*)(o + 4));
            __builtin_nontemporal_store((f32x4){bflo(h[q][1].x) * s0 * g10[0], bfhi(h[q][1].x) * s0 * g10[1], bflo(h[q][1].y) * s0 * g10[2], bfhi(h[q][1].y) * s0 * g10[3]}, (f32x4*)(o + 512));
            __builtin_nontemporal_store((f32x4){bflo(h[q][1].z) * s0 * g11[0], bfhi(h[q][1].z) * s0 * g11[1], bflo(h[q][1].w) * s0 * g11[2], bfhi(h[q][1].w) * s0 * g11[3]}, (f32x4*)(o + 516));
        }
    }
}

#define XB_TMO      128
#define XB_XCNT(j)  (256  + 64 * (j))
#define XB_XSUB(j)  (1280 + 64 * (j))
#define XB_XGEN(j)  (2304 + 64 * (j))
#define XB_TOP      3328
#define XB_TOPGEN   3392
#define XCD_BAR_WORDS 3456
#define XB_SPIN_CAP (1u << 18)
DEV unsigned xb_ld(unsigned* p) { return __hip_atomic_load(p, __ATOMIC_RELAXED, __HIP_MEMORY_SCOPE_AGENT); }
DEV unsigned xb_add(unsigned* p, unsigned v) { return __hip_atomic_fetch_add(p, v, __ATOMIC_RELAXED, __HIP_MEMORY_SCOPE_AGENT); }
DEV unsigned xb_xcc_id() { return (unsigned)__builtin_amdgcn_s_getreg((3 << 11) | 20) & 0xFu; }
#define XB_SPIN(cond, bar) do { unsigned _sp = 0; while (cond) { __builtin_amdgcn_s_sleep(1); \
    if ((++_sp & 255u) == 0u) { if (xb_ld(&(bar)[XB_TMO])) break; if (_sp > XB_SPIN_CAP) { atomicAdd(&(bar)[XB_TMO], 1u); break; } } } } while (0)
struct XcdBarrier { unsigned* bar; unsigned x; volatile LAS unsigned* st; };
DEV XcdBarrier xcd_barrier_post(unsigned* bar, volatile LAS unsigned* st) {
    XcdBarrier b; b.bar = bar; b.x = xb_xcc_id(); b.st = st;
    if (threadIdx.x == 0) (void)xb_add(&bar[XB_XCNT(b.x)], 1u);
    return b;
}
DEV void xcd_barrier_complete(unsigned* bar, unsigned x, unsigned& nloc, unsigned& nx) {
    const unsigned G = gridDim.x * gridDim.y * gridDim.z;
    unsigned sum, cnt, mine, sp = 0u;
    for (;;) {
        sum = 0u; cnt = 0u; mine = 0u;
#pragma unroll
        for (unsigned j = 0; j < 16; ++j) { const unsigned c = xb_ld(&bar[XB_XCNT(j)]); sum += c; cnt += (c > 0u) ? 1u : 0u; mine = (j == x) ? c : mine; }
        if (sum == G) break;
        __builtin_amdgcn_s_sleep(1);
        if ((++sp & 255u) == 0u) { if (xb_ld(&bar[XB_TMO])) break; if (sp > XB_SPIN_CAP) { atomicAdd(&bar[XB_TMO], 1u); break; } }
    }
    nloc = mine > 0u ? mine : 1u; nx = cnt > 0u ? cnt : 1u;
}
DEV void xcd_barrier(const XcdBarrier& b) {
    asm volatile("s_waitcnt vmcnt(0)" ::: "memory");
    __syncthreads();
    if (threadIdx.x == 0) {
        unsigned* bar = b.bar;
        __builtin_amdgcn_s_waitcnt(0);
        unsigned nloc = b.st[0], nx = b.st[1];
        if (nloc == 0u) { xcd_barrier_complete(bar, b.x, nloc, nx); b.st[0] = nloc; b.st[1] = nx; }
        const unsigned old = xb_add(&bar[XB_XSUB(b.x)], 1u);
        const unsigned gen = old / nloc;
        if (old + 1u == (gen + 1u) * nloc) {
            __builtin_amdgcn_fence(__ATOMIC_RELEASE, "agent");
            asm volatile("s_waitcnt vmcnt(0)" ::: "memory");
            const unsigned og = xb_add(&bar[XB_TOP], 1u);
            const unsigned tg = og / nx;
            if (og + 1u == (tg + 1u) * nx) xb_add(&bar[XB_TOPGEN], 1u);
            else XB_SPIN(xb_ld(&bar[XB_TOPGEN]) == tg, bar);
            __builtin_amdgcn_fence(__ATOMIC_ACQUIRE, "agent");
            xb_add(&bar[XB_XGEN(b.x)], 1u);
            asm volatile("s_waitcnt vmcnt(0)" ::: "memory");
        } else {
            XB_SPIN(xb_ld(&bar[XB_XGEN(b.x)]) == gen, bar);
            __builtin_amdgcn_fence(__ATOMIC_ACQUIRE, "agent");
            asm volatile("s_waitcnt vmcnt(0)" ::: "memory");
        }
    }
    __syncthreads();
}

#if MEGA
__global__ void __launch_bounds__(NT, 2) fwd_mega(Params p) {
    extern __shared__ __attribute__((aligned(16))) unsigned char lds_raw[];
    LAS unsigned char* lds = (LAS unsigned char*)lds_raw;
    cg::grid_group grid = cg::this_grid();
    if (threadIdx.x < 4) ((LAS unsigned*)(lds + LDS_CTL))[threadIdx.x] = 0u;
    __syncthreads();
    XcdBarrier bar = xcd_barrier_post((unsigned*)(p.ws + WS_BAR), (volatile LAS unsigned*)(lds + LDS_CTL));
    phase_prologue(p, lds);
    if (p.ws == nullptr) grid.sync();
    xcd_barrier(bar);
    for (int l = 0; l < DEPTH; ++l) {
        phase_gemm1(p, l, lds); xcd_barrier(bar);
        phase_dft(p, lds); phase_xa(p, l, lds); xcd_barrier(bar);
        phase_gemm2(p, l, lds); xcd_barrier(bar);
        phase_gemm3(p, l, lds); xcd_barrier(bar);
        phase_gemm4(p, l, lds); xcd_barrier(bar);
    }
    phase_final(p);
}
#else
template <int PH> __global__ void __launch_bounds__(NT, 2) phase_kernel(Params p, int l) {
    extern __shared__ __attribute__((aligned(16))) unsigned char lds_raw[];
    LAS unsigned char* lds = (LAS unsigned char*)lds_raw;
    if (PH == 0) phase_prologue(p, lds);
    if (PH == 1) phase_gemm1(p, l, lds);
    if (PH == 2) {}
    if (PH == 3) { phase_dft(p, lds); phase_xa(p, l, lds); }
    if (PH == 4) phase_gemm2(p, l, lds);
    if (PH == 5) phase_gemm3(p, l, lds);
    if (PH == 6) phase_gemm4(p, l, lds);
    if (PH == 7) phase_final(p);
}
template <int PH> static void launch_phase(const Params& p, int l, hipStream_t stream) {
    static bool attr = false;
    if (!attr) { (void)hipFuncSetAttribute((const void*)phase_kernel<PH>, hipFuncAttributeMaxDynamicSharedMemorySize, LDS_BYTES); attr = true; }
    hipLaunchKernelGGL(phase_kernel<PH>, dim3(256), dim3(NT), LDS_BYTES, stream, p, l);
}
#endif

extern "C" void kernel_launch(void* const* d_in, const int* in_sizes, int n_in, void* d_out, int out_size, void* d_ws, size_t ws_size, hipStream_t stream) {
    if (n_in != 14 || ws_size < WS_END || out_size != TX * D) { fprintf(stderr, "kernel_launch: unexpected shapes (n_in %d, ws %zu need %zu, out %d)\n", n_in, ws_size, (size_t)WS_END, out_size); return; }
    Params p{};
    p.x_prompt = (const float*)d_in[0]; p.x_sample = (const float*)d_in[1]; p.meta = (const float*)d_in[2]; p.norm1_g = (const float*)d_in[3];
    p.w_in = (const float*)d_in[4]; p.conv_w = (const float*)d_in[5]; p.pool_w = (const float*)d_in[6]; p.pool_scale = (const float*)d_in[7];
    p.mix_g = (const float*)d_in[8]; p.w_out = (const float*)d_in[9]; p.norm2_g = (const float*)d_in[10]; p.w_gate_up = (const float*)d_in[11];
    p.w_down = (const float*)d_in[12]; p.final_g = (const float*)d_in[13];
    p.out = (float*)d_out; p.ws = (unsigned char*)d_ws;
#if MEGA
    static int grid = 0;
    if (grid == 0) {
        int dev = 0, cus = 0, per_cu = 0;
        (void)hipGetDevice(&dev);
        (void)hipDeviceGetAttribute(&cus, hipDeviceAttributeMultiprocessorCount, dev);
        (void)hipFuncSetAttribute((const void*)fwd_mega, hipFuncAttributeMaxDynamicSharedMemorySize, LDS_BYTES);
        (void)hipOccupancyMaxActiveBlocksPerMultiprocessor(&per_cu, (const void*)fwd_mega, NT, LDS_BYTES);
        if (per_cu < 1) per_cu = 1;
        grid = cus * per_cu;
        if (grid > 256) grid = 256;
    }
    (void)hipMemsetAsync((unsigned char*)d_ws + WS_BAR, 0, XCD_BAR_WORDS_C * 4, stream);
    void* args[] = {&p};
    hipError_t e = hipLaunchCooperativeKernel((const void*)fwd_mega, dim3(grid), dim3(NT), args, LDS_BYTES, stream);
    if (e != hipSuccess) fprintf(stderr, "cooperative launch failed: %s (grid %d)\n", hipGetErrorString(e), grid);
#else
    launch_phase<0>(p, 0, stream);
    for (int l = 0; l < DEPTH; ++l) {
        launch_phase<1>(p, l, stream); launch_phase<2>(p, l, stream); launch_phase<3>(p, l, stream);
        launch_phase<4>(p, l, stream); launch_phase<5>(p, l, stream); launch_phase<6>(p, l, stream);
    }
    launch_phase<7>(p, 0, stream);
#endif
}
```

```cpp
#include <hip/hip_runtime.h>
#include <hip/hip_cooperative_groups.h>
#include <cstdio>
#include <cstdint>
namespace cg = cooperative_groups;

#ifndef MEGA
#define MEGA 1
#endif

#define LAS __attribute__((address_space(3)))
#define DEV __device__ __forceinline__
typedef unsigned short bf16_t;
typedef short bf16x8 __attribute__((ext_vector_type(8)));
typedef float f32x4 __attribute__((ext_vector_type(4)));
typedef float f32x2 __attribute__((ext_vector_type(2)));
typedef unsigned u32x4 __attribute__((ext_vector_type(4)));
typedef unsigned u32x2 __attribute__((ext_vector_type(2)));

constexpr int D = 1024, NZ = 2048, DFF = 2816, NGU = 5632, DEPTH = 4, NIN0 = 1792;
constexpr int TX = 49152, TMETA = 144, T = TX + TMETA, TP = TX + 256;
constexpr int LP = 16400, LS = 4112, L2P = 1025, L2S = 257;
constexpr int KHP = 1088, KHS = 320, KP = 2 * KHP, KS = 2 * KHS, MPP = 1280, MPS = 512;
constexpr int NCP = 4096, NCS = 32768;
constexpr int NGROUPS = 3081;
constexpr float EPS = 1e-6f;
constexpr int LDS_BYTES = 131072 + 8192 + 16;
constexpr int NT = 512;
constexpr int XCD_BAR_WORDS_C = 3456 + 256;
constexpr int VCNT_WORD0 = 3456;
constexpr int MCNT_WORD0 = 3456 + 32;
constexpr int NVTILES = 192 + 9;
constexpr int LDS_EX = 131072;
constexpr int LDS_CTL = 131072 + 8192;

constexpr size_t al(size_t x) { return (x + 255) & ~size_t(255); }
constexpr size_t WS_W1 = 0;
constexpr size_t WS_W2 = WS_W1 + al((size_t)DEPTH * NZ * D * 2);
constexpr size_t WS_W3 = WS_W2 + al((size_t)DEPTH * D * D * 2);
constexpr size_t WS_W4 = WS_W3 + al((size_t)DEPTH * NGU * D * 2);
constexpr size_t WS_PW = WS_W4 + al((size_t)DEPTH * D * DFF * 2);
constexpr size_t WS_DP = WS_PW + al((size_t)DEPTH * 4 * 96 * 96 * 2);
constexpr size_t WS_DS = WS_DP + al((size_t)MPP * KP * 2);
constexpr size_t WS_TWP = WS_DS + al((size_t)MPS * KS * 2);
constexpr size_t WS_TWS = WS_TWP + al((size_t)16 * KHP * 8);
constexpr size_t WS_SS1 = WS_TWS + al((size_t)16 * KHS * 8);
constexpr size_t WS_SS2 = WS_SS1 + al((size_t)TP * 4 * 4);
constexpr size_t WS_HM = WS_SS2 + al((size_t)TP * 4 * 4);
constexpr size_t WS_HB = WS_HM + al((size_t)256 * D * 4);
constexpr size_t WS_Z = WS_HB + al((size_t)TP * D * 2);
constexpr size_t WS_MIX = WS_Z + al((size_t)TP * NZ * 2);
constexpr size_t WS_BAR = WS_MIX + al((size_t)TP * D * 2);
constexpr size_t WS_END = WS_BAR + al((size_t)XCD_BAR_WORDS_C * 4);
constexpr size_t OUT_WBP = 0;
constexpr size_t OUT_WBS = (size_t)KP * NCP * 2;
constexpr size_t WS_ACT = WS_Z;
static_assert((size_t)KP * NCP * 2 + (size_t)KS * NCS * 2 <= (size_t)TX * D * 4, "WB in d_out");
static_assert((size_t)TP * DFF * 2 <= (WS_BAR - WS_Z), "ACT overlay");

struct Params {
    const float *x_prompt, *x_sample, *meta, *norm1_g, *w_in, *conv_w, *pool_w, *pool_scale, *mix_g, *w_out, *norm2_g, *w_gate_up, *w_down, *final_g;
    float* out; unsigned char* ws;
};

DEV unsigned cvt_pk_bf16(float lo, float hi) { unsigned r; asm("v_cvt_pk_bf16_f32 %0, %1, %2" : "=v"(r) : "v"(lo), "v"(hi)); return r; }
DEV float bflo(unsigned w) { return __uint_as_float(w << 16); }
DEV float bfhi(unsigned w) { return __uint_as_float(w & 0xffff0000u); }
DEV float bf2f(bf16_t v) { return __uint_as_float((unsigned)v << 16); }

DEV u32x4 pack8(const float (&v)[8]) { u32x4 w; w.x = cvt_pk_bf16(v[0], v[1]); w.y = cvt_pk_bf16(v[2], v[3]); w.z = cvt_pk_bf16(v[4], v[5]); w.w = cvt_pk_bf16(v[6], v[7]); return w; }

typedef __amdgpu_buffer_rsrc_t rsrc_t;
DEV rsrc_t make_rsrc(const void* base, unsigned bytes) { return __builtin_amdgcn_make_buffer_rsrc((void*)base, 0, (int)bytes, 0x00020000); }
DEV void st16_wt(rsrc_t r, unsigned byte_off, u32x4 v) { __builtin_amdgcn_raw_buffer_store_b128(v, r, byte_off, 0, 16); }

DEV int seq_xbase(int s) { return s == 0 ? 0 : 16384 + 4096 * (s - 1); }
DEV int rowof(int s, int p) { return p < 16 ? TX + 16 * s + p : seq_xbase(s) + p - 16; }

DEV int swz_off(int fr, int fq) { int ob = fr * 64 + fq * 16; return ob ^ (((ob >> 9) & 1) << 5); }
DEV void stage_rc(int b, int& R, int& C) { int st = b >> 10, sb = b & 1023, swz = sb ^ (((sb >> 9) & 1) << 5); R = (st >> 1) * 16 + (swz >> 6); C = (st & 1) * 32 + ((swz & 63) >> 1); }

#define GLDS(g, l) __builtin_amdgcn_global_load_lds((const unsigned*)(g), (LAS unsigned*)(l), 16, 0, 0)
#define WAIT_V(n) asm volatile("s_waitcnt vmcnt(" #n ")" ::: "memory")
#define WAIT_L(n) asm volatile("s_waitcnt lgkmcnt(" #n ")" ::: "memory")
#define BAR __builtin_amdgcn_s_barrier()
#define SCHED __builtin_amdgcn_sched_barrier(0)

template <int BMODE, class Epi, class TileFn>
DEV void gemm_loop(LAS unsigned char* lds, const bf16_t* __restrict__ A, int lda, const bf16_t* __restrict__ B, int ldb, int K, const Epi& epi, int t0, int tstep, int tend, const TileFn& tf) {
    if (t0 >= tend) return;
    int tid = threadIdx.x; asm volatile("" : "+v"(tid));
    const int wid = tid >> 6, lane = tid & 63, wr = wid >> 2, wc = wid & 3, fr = lane & 15, fq = lane >> 4;
    int r0, c0; stage_rc(tid * 16, r0, c0);
    const unsigned voa0 = (unsigned)(r0 * lda + c0) * 2u, voa1 = voa0 + (unsigned)(64 * lda) * 2u;
    const size_t ahalf = (size_t)128 * lda * 2;
    unsigned vob0, vob1; size_t bks, bhalf;
    const int r0b = Epi::PERM ? ((r0 & ~31) + 8 * ((r0 & 15) >> 2) + 4 * ((r0 >> 4) & 1) + (r0 & 3)) : r0;
    if (BMODE == 0) { vob0 = (unsigned)(r0b * ldb + c0) * 2u; vob1 = vob0 + (unsigned)(64 * ldb) * 2u; bks = 128; bhalf = (size_t)128 * ldb * 2; }
    else { vob0 = (unsigned)((c0 >> 3) * ldb + r0b) * 16u; vob1 = vob0 + 64u * 16u; bks = (size_t)ldb * 128; bhalf = 128 * 16; }
    LAS unsigned char* lw = lds + tid * 16;
    const int sw = swz_off(fr, fq);
    LAS unsigned char* la = lds + wr * 8192 + sw;
    LAS unsigned char* lb = lds + 65536 + wc * 4096 + sw;
    int brow, bcol; tf(t0, brow, bcol);
    const char* cA = (const char*)(A + (size_t)brow * lda);
    const char* cB = BMODE == 0 ? (const char*)(B + (size_t)bcol * ldb) : (const char*)(B + (size_t)bcol * 8);

#define STG_A(b, h, ptr) do { const char* _g = (ptr) + (h) * ahalf; LAS unsigned char* _l = lw + ((b) * 2 + (h)) * 16384; GLDS(_g + voa0, _l); GLDS(_g + voa1, _l + 8192); } while (0)
#define STG_B(b, h, ptr) do { const char* _g = (ptr) + (h) * bhalf; LAS unsigned char* _l = lw + 65536 + ((b) * 2 + (h)) * 16384; GLDS(_g + vob0, _l); GLDS(_g + vob1, _l + 8192); } while (0)
#define LDA(dst, b, h) _Pragma("unroll") for (int m = 0; m < 4; ++m) _Pragma("unroll") for (int k = 0; k < 2; ++k) dst[m][k] = *(const LAS bf16x8*)(la + ((b) * 2 + (h)) * 16384 + m * 2048 + k * 1024)
#define LDB(dst, b, h) _Pragma("unroll") for (int n = 0; n < 2; ++n) _Pragma("unroll") for (int k = 0; k < 2; ++k) dst[n][k] = *(const LAS bf16x8*)(lb + ((b) * 2 + (h)) * 16384 + n * 2048 + k * 1024)
#define MMA(ai, bj, Af, Bf) do { __builtin_amdgcn_s_setprio(1); \
    _Pragma("unroll") for (int m = 0; m < 4; ++m) _Pragma("unroll") for (int n = 0; n < 2; ++n) _Pragma("unroll") for (int k = 0; k < 2; ++k) \
        acc[ai][bj][m][n] = __builtin_amdgcn_mfma_f32_16x16x32_bf16(Bf[n][k], Af[m][k], acc[ai][bj][m][n], 0, 0, 0); \
    __builtin_amdgcn_s_setprio(0); } while (0)

    const int nt = K / 64;
    f32x4 acc[2][2][4][2];
#pragma unroll
    for (int a = 0; a < 2; ++a)
#pragma unroll
        for (int b = 0; b < 2; ++b)
#pragma unroll
            for (int m = 0; m < 4; ++m)
#pragma unroll
                for (int n = 0; n < 2; ++n) acc[a][b][m][n] = (f32x4){0.f, 0.f, 0.f, 0.f};
    bf16x8 At[4][2], B0[2][2], B1[2][2];
    STG_B(0, 0, cB); STG_B(0, 1, cB); STG_A(0, 0, cA); STG_A(0, 1, cA);
    if (wr == 1) BAR;
    WAIT_V(2); BAR;
    STG_B(1, 0, cB + bks); STG_A(1, 0, cA + 128); STG_B(1, 1, cB + bks);
    WAIT_V(6); BAR;
    int par = 0;
    for (int tt = t0;; tt += tstep, par ^= 1) {
        const bool has_next = tt + tstep < tend;
        epi.prefetch(lds, brow, par, tid);
        int nrow = brow, ncol = bcol;
        if (has_next) tf(tt + tstep, nrow, ncol);
        const char* nA = (const char*)(A + (size_t)nrow * lda);
        const char* nB = BMODE == 0 ? (const char*)(B + (size_t)ncol * ldb) : (const char*)(B + (size_t)ncol * 8);
        for (int t = 0; t < nt; t += 2) {
            const bool last = (t == nt - 2);
            const char* a1 = cA + (size_t)(t + 1) * 128;
            const char* a2 = last ? nA : cA + (size_t)(t + 2) * 128;
            const char* b2 = last ? nB : cB + (size_t)(t + 2) * bks;
            const char* a3 = a2 + 128; const char* b3 = b2 + bks;
            LDB(B0, 0, 0); LDB(B1, 0, 1); SCHED; LDA(At, 0, 0); STG_A(1, 1, a1);
            WAIT_V(8); WAIT_L(0); BAR; MMA(0, 0, At, B0); MMA(0, 1, At, B1); BAR; SCHED;
            LDA(At, 0, 1); STG_B(0, 0, b2); STG_B(0, 1, b2); STG_A(0, 0, a2);
            WAIT_V(8); WAIT_L(0); BAR; MMA(1, 0, At, B0); MMA(1, 1, At, B1); BAR; SCHED;
            LDB(B0, 1, 0); LDB(B1, 1, 1); SCHED; LDA(At, 1, 0); STG_A(0, 1, a2);
            WAIT_V(8); WAIT_L(0); BAR; MMA(0, 0, At, B0); MMA(0, 1, At, B1); BAR; SCHED;
            LDA(At, 1, 1); STG_B(1, 0, b3); STG_B(1, 1, b3); STG_A(1, 0, a3);
            WAIT_V(8); WAIT_L(0); BAR; MMA(1, 0, At, B0); MMA(1, 1, At, B1); BAR; SCHED;
        }
        if (wr == 0) BAR;
        epi(acc, brow, bcol, lds, par);
        if (!has_next) break;
#pragma unroll
        for (int a = 0; a < 2; ++a)
#pragma unroll
            for (int b = 0; b < 2; ++b)
#pragma unroll
                for (int m = 0; m < 4; ++m)
#pragma unroll
                    for (int n = 0; n < 2; ++n) acc[a][b][m][n] = (f32x4){0.f, 0.f, 0.f, 0.f};
        brow = nrow; bcol = ncol; cA = nA; cB = nB;
        if (wr == 1) BAR;
    }
    WAIT_V(0);
    BAR;
#undef STG_A
#undef STG_B
#undef LDA
#undef LDB
#undef MMA
}

DEV void skinny_reduce(LAS unsigned char* lds, int wid, int lane, const f32x4 (&acc)[16], f32x4& a0, f32x4& a1) {
#pragma unroll
    for (int nb = 0; nb < 16; ++nb) *(LAS f32x4*)(lds + ((wid * 16 + nb) * 64 + lane) * 16) = acc[nb];
    __syncthreads();
    a0 = (f32x4){0.f, 0.f, 0.f, 0.f}; a1 = a0;
#pragma unroll
    for (int w = 0; w < 8; ++w) { a0 += *(const LAS f32x4*)(lds + ((w * 16 + 2 * wid) * 64 + lane) * 16); a1 += *(const LAS f32x4*)(lds + ((w * 16 + 2 * wid + 1) * 64 + lane) * 16); }
    __syncthreads();
}
template <class Epi>
DEV void skinny_item(LAS unsigned char* lds, const bf16_t* __restrict__ A, int lda, const bf16_t* __restrict__ B, int ldb, int K, int mb, int pn, const Epi& epi) {
    int tid = threadIdx.x; asm volatile("" : "+v"(tid));
    const int wid = tid >> 6, lane = tid & 63, fr = lane & 15, fq = lane >> 4;
    const bf16_t* ap = A + (size_t)(TX + mb * 16 + fr) * lda + fq * 8;
    const bf16_t* bp = B + (size_t)(pn * 256 + fr) * ldb + fq * 8;
    const size_t b16 = (size_t)16 * ldb;
    f32x4 acc[16];
#pragma unroll
    for (int nb = 0; nb < 16; ++nb) acc[nb] = (f32x4){0.f, 0.f, 0.f, 0.f};
    const int nsteps = K >> 5;
#pragma unroll 1
    for (int st = wid; st < nsteps; st += 8) {
        const int k0 = st * 32;
        const bf16x8 a = *(const bf16x8*)(ap + k0);
        bf16x8 b[16];
#pragma unroll
        for (int nb = 0; nb < 16; ++nb) b[nb] = *(const bf16x8*)(bp + nb * b16 + k0);
        SCHED;
#pragma unroll
        for (int nb = 0; nb < 16; ++nb) acc[nb] = __builtin_amdgcn_mfma_f32_16x16x32_bf16(b[nb], a, acc[nb], 0, 0, 0);
        SCHED;
    }
    f32x4 a0, a1;
    skinny_reduce(lds, wid, lane, acc, a0, a1);
    epi.skinny(a0, a1, mb, pn, lds);
}

template <class Epi>
DEV void skinny_dft(LAS unsigned char* lds, const bf16_t* __restrict__ A, int lda, const bf16_t* __restrict__ B, int N, int K, int arow0, int ncol0, const Epi& epi) {
    int tid = threadIdx.x; asm volatile("" : "+v"(tid));
    const int wid = tid >> 6, lane = tid & 63, fr = lane & 15, fq = lane >> 4;
    const bf16_t* ap = A + (size_t)(arow0 + fr) * lda + fq * 8;
    const bf16_t* bp = B + ((size_t)fq * N + ncol0 + fr) * 8;
    const size_t bstep = (size_t)4 * N * 8;
    f32x4 acc[16];
#pragma unroll
    for (int nb = 0; nb < 16; ++nb) acc[nb] = (f32x4){0.f, 0.f, 0.f, 0.f};
    const int nsteps = K >> 5;
#pragma unroll 1
    for (int st = wid; st < nsteps; st += 8) {
        const bf16x8 a = *(const bf16x8*)(ap + st * 32);
        const bf16_t* bq = bp + st * bstep;
        bf16x8 b[16];
#pragma unroll
        for (int nb = 0; nb < 16; ++nb) b[nb] = *(const bf16x8*)(bq + nb * 128);
        SCHED;
#pragma unroll
        for (int nb = 0; nb < 16; ++nb) acc[nb] = __builtin_amdgcn_mfma_f32_16x16x32_bf16(b[nb], a, acc[nb], 0, 0, 0);
        SCHED;
    }
    f32x4 a0, a1;
    skinny_reduce(lds, wid, lane, acc, a0, a1);
    epi.skinny(a0, a1, lds);
}

struct TileMap { int nM, nN; DEV void operator()(int t, int& brow, int& bcol) const; };
struct TileMapRev { int nM, nN; DEV void operator()(int t, int& brow, int& bcol) const; };
struct TileG1 { DEV void operator()(int t, int& brow, int& bcol) const; };
struct TileOne { int brow_, bcol_; DEV void operator()(int, int& brow, int& bcol) const { brow = brow_; bcol = bcol_; } };

DEV void tile_map(int L, int nM, int nN, int& pm, int& pn) {
    const int nwg = nM * nN; int wgid = L;
    { const int q = nwg / 8, r = nwg % 8, xcd = wgid % 8, off = wgid / 8; wgid = (xcd < r ? xcd * (q + 1) : r * (q + 1) + (xcd - r) * q) + off; }
    const int nig = 4 * nN, gid = wgid / nig, fm = gid * 4, gsz = (nM - fm) < 4 ? (nM - fm) : 4;
    pm = fm + ((wgid % nig) % gsz); pn = (wgid % nig) / gsz;
}

DEV void TileMap::operator()(int t, int& brow, int& bcol) const { int pm, pn; tile_map(t, nM, nN, pm, pn); brow = pm * 256; bcol = pn * 256; }
DEV void TileG1::operator()(int t, int& brow, int& bcol) const { int pm, pn; tile_map(t, 192, 7, pm, pn); brow = pm * 256; bcol = (pn == 0 ? 6 : pn - 1) * 256; }
DEV void TileMapRev::operator()(int t, int& brow, int& bcol) const { int pm, pn; tile_map(t, nM, nN, pm, pn); brow = (nM - 1 - pm) * 256; bcol = pn * 256; }

#define EPI_IDS int tid = threadIdx.x; asm volatile("" : "+v"(tid)); const int wid = tid >> 6, lane = tid & 63, wr = wid >> 2, wc = wid & 3, fr = lane & 15, fq = lane >> 4; (void)wc; (void)fq; (void)fr; (void)wr;

DEV float row_rs(const float* ss, int row) { const f32x4 s4 = *(const f32x4*)(ss + (size_t)row * 4); return rsqrtf(((s4[0] + s4[1]) + (s4[2] + s4[3])) * (1.0f / 1024.0f) + EPS); }

struct Epi1 {
    static constexpr bool PERM = true;
    bf16_t* z; const float* ss; unsigned* vcnt;
    DEV void prefetch(LAS unsigned char* lds, int brow, int par, int tid) const { if (tid < 256) GLDS(ss + (size_t)(brow + tid) * 4, lds + LDS_EX + par * 4096 + tid * 16); }
    DEV void publish(int tid) const {
        asm volatile("s_waitcnt vmcnt(0)" ::: "memory");
        __syncthreads();
        if (tid == 0) (void)__hip_atomic_fetch_add(vcnt, 1u, __ATOMIC_RELAXED, __HIP_MEMORY_SCOPE_AGENT);
    }
    DEV void publish_fenced(int tid) const {
        asm volatile("s_waitcnt vmcnt(0)" ::: "memory");
        __syncthreads();
        if (tid == 0) { __builtin_amdgcn_fence(__ATOMIC_RELEASE, "agent"); asm volatile("s_waitcnt vmcnt(0)" ::: "memory"); (void)__hip_atomic_fetch_add(vcnt, 1u, __ATOMIC_RELAXED, __HIP_MEMORY_SCOPE_AGENT); }
    }
    DEV void operator()(f32x4 (&acc)[2][2][4][2], int brow, int bcol, LAS unsigned char* lds, int par) const {
        EPI_IDS
        const rsrc_t zr = make_rsrc(z, (unsigned)((size_t)TP * NZ * 2));
        const bool vt = bcol == 6 * 256;
#pragma unroll
        for (int ai = 0; ai < 2; ++ai)
#pragma unroll
            for (int m = 0; m < 4; ++m) {
                const int lr = ai * 128 + wr * 64 + m * 16 + fr, row = brow + lr;
                const f32x4 s4 = *(const LAS f32x4*)(lds + LDS_EX + par * 4096 + lr * 16);
                const float rs = rsqrtf(((s4[0] + s4[1]) + (s4[2] + s4[3])) * (1.0f / 1024.0f) + EPS);
#pragma unroll
                for (int bj = 0; bj < 2; ++bj) {
                    const f32x4 v0 = acc[ai][bj][m][0] * rs, v1 = acc[ai][bj][m][1] * rs;
                    u32x4 w; w.x = cvt_pk_bf16(v0[0], v0[1]); w.y = cvt_pk_bf16(v0[2], v0[3]); w.z = cvt_pk_bf16(v1[0], v1[1]); w.w = cvt_pk_bf16(v1[2], v1[3]);
                    if (vt) st16_wt(zr, (unsigned)(row * NZ + bcol + bj * 128 + wc * 32 + fq * 8) * 2u, w);
                    else *(u32x4*)(z + (size_t)row * NZ + bcol + bj * 128 + wc * 32 + fq * 8) = w;
                }
            }
        if (vt) publish(tid);
    }
    DEV void skinny(f32x4 a0, f32x4 a1, int mb, int pn, LAS unsigned char*) const {
        EPI_IDS
        const int row = TX + mb * 16 + fr;
        const float rs = row_rs(ss, row);
        const f32x4 v0 = a0 * rs, v1 = a1 * rs;
        bf16_t* zp = z + (size_t)row * NZ + pn * 256 + wid * 32 + fq * 4;
        *(u32x2*)zp = (u32x2){cvt_pk_bf16(v0[0], v0[1]), cvt_pk_bf16(v0[2], v0[3])};
        *(u32x2*)(zp + 16) = (u32x2){cvt_pk_bf16(v1[0], v1[1]), cvt_pk_bf16(v1[2], v1[3])};
        if (pn == 6) publish_fenced(tid);
    }
};

struct EpiRes {
    static constexpr bool PERM = true;
    bf16_t* hb; float* ssout;
    DEV void prefetch(LAS unsigned char*, int, int, int) const {}
    DEV void operator()(f32x4 (&acc)[2][2][4][2], int brow, int bcol, LAS unsigned char* lds, int) const {
        EPI_IDS
        LAS float* ex = (LAS float*)(lds + LDS_EX);
        bf16_t* hp0 = hb + (size_t)(brow + wr * 64 + fr) * D + bcol + wc * 32 + fq * 8;
        u32x4 res[2][4][2];
#pragma unroll
        for (int ai = 0; ai < 2; ++ai)
#pragma unroll
            for (int m = 0; m < 4; ++m)
#pragma unroll
                for (int bj = 0; bj < 2; ++bj) res[ai][m][bj] = *(const u32x4*)(hp0 + (size_t)(ai * 128 + m * 16) * D + bj * 128);
        SCHED;
#pragma unroll
        for (int ai = 0; ai < 2; ++ai)
#pragma unroll
            for (int m = 0; m < 4; ++m) {
                const int lr = ai * 128 + wr * 64 + m * 16 + fr;
                float s = 0.f;
#pragma unroll
                for (int bj = 0; bj < 2; ++bj) {
                    const u32x4 r = res[ai][m][bj];
                    f32x4 v0 = acc[ai][bj][m][0], v1 = acc[ai][bj][m][1];
                    v0[0] += bflo(r.x); v0[1] += bfhi(r.x); v0[2] += bflo(r.y); v0[3] += bfhi(r.y);
                    v1[0] += bflo(r.z); v1[1] += bfhi(r.z); v1[2] += bflo(r.w); v1[3] += bfhi(r.w);
                    u32x4 w; w.x = cvt_pk_bf16(v0[0], v0[1]); w.y = cvt_pk_bf16(v0[2], v0[3]); w.z = cvt_pk_bf16(v1[0], v1[1]); w.w = cvt_pk_bf16(v1[2], v1[3]);
                    *(u32x4*)(hp0 + (size_t)(ai * 128 + m * 16) * D + bj * 128) = w;
                    s += ((v0[0] * v0[0] + v0[1] * v0[1]) + (v0[2] * v0[2] + v0[3] * v0[3])) + ((v1[0] * v1[0] + v1[1] * v1[1]) + (v1[2] * v1[2] + v1[3] * v1[3]));
                }
                s += __shfl_xor(s, 16); s += __shfl_xor(s, 32);
                if (fq == 0) ex[lr * 4 + wc] = s;
            }
        __syncthreads();
        if (tid < 256) { const f32x4 e = *(const LAS f32x4*)(ex + tid * 4); ssout[(size_t)(brow + tid) * 4 + (bcol >> 8)] = (e[0] + e[1]) + (e[2] + e[3]); }
    }
    DEV void skinny(f32x4 a0, f32x4 a1, int mb, int pn, LAS unsigned char* lds) const {
        EPI_IDS
        const int row = TX + mb * 16 + fr, col = pn * 256 + wid * 32 + fq * 4;
        bf16_t* bp = hb + (size_t)row * D + col;
        const u32x2 r0 = *(const u32x2*)bp, r1 = *(const u32x2*)(bp + 16);
        f32x4 v0 = a0, v1 = a1;
        v0[0] += bflo(r0.x); v0[1] += bfhi(r0.x); v0[2] += bflo(r0.y); v0[3] += bfhi(r0.y);
        v1[0] += bflo(r1.x); v1[1] += bfhi(r1.x); v1[2] += bflo(r1.y); v1[3] += bfhi(r1.y);
        *(u32x2*)bp = (u32x2){cvt_pk_bf16(v0[0], v0[1]), cvt_pk_bf16(v0[2], v0[3])};
        *(u32x2*)(bp + 16) = (u32x2){cvt_pk_bf16(v1[0], v1[1]), cvt_pk_bf16(v1[2], v1[3])};
        float s = ((v0[0] * v0[0] + v0[1] * v0[1]) + (v0[2] * v0[2] + v0[3] * v0[3])) + ((v1[0] * v1[0] + v1[1] * v1[1]) + (v1[2] * v1[2] + v1[3] * v1[3]));
        s += __shfl_xor(s, 16); s += __shfl_xor(s, 32);
        LAS float* ex = (LAS float*)(lds + LDS_EX);
        if (fq == 0) ex[fr * 8 + wid] = s;
        __syncthreads();
        if (tid < 16) { const f32x4 e0 = *(const LAS f32x4*)(ex + tid * 8), e1 = *(const LAS f32x4*)(ex + tid * 8 + 4);
            ssout[(size_t)(TX + mb * 16 + tid) * 4 + pn] = ((e0[0] + e0[1]) + (e0[2] + e0[3])) + ((e1[0] + e1[1]) + (e1[2] + e1[3])); }
        __syncthreads();
    }
};

struct Epi3 {
    static constexpr bool PERM = false;
    bf16_t* act; const float* ss; unsigned* mcnt;
    DEV void prefetch(LAS unsigned char* lds, int brow, int par, int tid) const { if (tid < 256) GLDS(ss + (size_t)(brow + tid) * 4, lds + LDS_EX + par * 4096 + tid * 16); }
    DEV void operator()(f32x4 (&acc)[2][2][4][2], int brow, int bcol, LAS unsigned char* lds, int par) const {
        EPI_IDS
#pragma unroll
        for (int ai = 0; ai < 2; ++ai)
#pragma unroll
            for (int m = 0; m < 4; ++m) {
                const int lr = ai * 128 + wr * 64 + m * 16 + fr, row = brow + lr;
                const f32x4 s4 = *(const LAS f32x4*)(lds + LDS_EX + par * 4096 + lr * 16);
                const float rs = rsqrtf(((s4[0] + s4[1]) + (s4[2] + s4[3])) * (1.0f / 1024.0f) + EPS);
                float o[8];
                const float rs2 = rs * rs, ce = rs * -1.4426950408889634f;
#pragma unroll
                for (int bj = 0; bj < 2; ++bj) {
                    const f32x4 g = acc[ai][bj][m][0], u = acc[ai][bj][m][1];
#pragma unroll
                    for (int j = 0; j < 4; ++j) o[bj * 4 + j] = (g[j] * u[j]) * rs2 * __builtin_amdgcn_rcpf(1.0f + __builtin_amdgcn_exp2f(g[j] * ce));
                }
                *(u32x4*)(act + (size_t)row * DFF + (bcol >> 1) + wc * 32 + fq * 8) = pack8(o);
            }
    }
    DEV void skinny(f32x4 a0, f32x4 a1, int mb, int pn, LAS unsigned char*) const {
        EPI_IDS
        const int row = TX + mb * 16 + fr;
        const float rs = row_rs(ss, row);
        const f32x4 g = a0 * rs, u = a1 * rs;
        float o[4];
#pragma unroll
        for (int j = 0; j < 4; ++j) o[j] = g[j] * __builtin_amdgcn_rcpf(1.0f + __expf(-g[j])) * u[j];
        *(u32x2*)(act + (size_t)row * DFF + pn * 128 + (wid & 3) * 32 + fq * 8 + (wid >> 2) * 4) = (u32x2){cvt_pk_bf16(o[0], o[1]), cvt_pk_bf16(o[2], o[3])};
        asm volatile("s_waitcnt vmcnt(0)" ::: "memory");
        __syncthreads();
        if (tid == 0) { __builtin_amdgcn_fence(__ATOMIC_RELEASE, "agent"); asm volatile("s_waitcnt vmcnt(0)" ::: "memory"); (void)__hip_atomic_fetch_add(mcnt, 1u, __ATOMIC_RELAXED, __HIP_MEMORY_SCOPE_AGENT); }
    }
};

struct EpiF {
    static constexpr bool PERM = true;
    bf16_t* mix; int s, k1, L2;
    DEV void prefetch(LAS unsigned char*, int, int, int) const {}
    DEV void operator()(f32x4 (&acc)[2][2][4][2], int brow, int bcol, LAS unsigned char* lds, int) const {
        EPI_IDS
        LAS float* ex = (LAS float*)(lds + LDS_EX);
#pragma unroll
        for (int ai = 0; ai < 2; ++ai)
#pragma unroll
            for (int m = 0; m < 4; ++m) {
                const int lr = ai * 128 + wr * 64 + m * 16 + fr;
                float q = 0.f;
#pragma unroll
                for (int bj = 0; bj < 2; ++bj)
#pragma unroll
                    for (int n = 0; n < 2; ++n) { const f32x4 v = acc[ai][bj][m][n]; q += (v[0] * v[0] + v[1] * v[1]) + (v[2] * v[2] + v[3] * v[3]); }
                q += __shfl_xor(q, 16); q += __shfl_xor(q, 32);
                if (fq == 0) ex[lr * 4 + wc] = q;
            }
        __syncthreads();
#pragma unroll
        for (int ai = 0; ai < 2; ++ai)
#pragma unroll
            for (int m = 0; m < 4; ++m) {
                const int lr = ai * 128 + wr * 64 + m * 16 + fr, k2 = brow + lr;
                const f32x4 e = *(const LAS f32x4*)(ex + lr * 4);
                const float rs = rsqrtf(((e[0] + e[1]) + (e[2] + e[3])) * (1.0f / 256.0f) + EPS);
                if (k2 < L2) {
                    const int row = rowof(s, k1 + 16 * k2);
#pragma unroll
                    for (int bj = 0; bj < 2; ++bj) {
                        const f32x4 v0 = acc[ai][bj][m][0] * rs, v1 = acc[ai][bj][m][1] * rs;
                        u32x4 w; w.x = cvt_pk_bf16(v0[0], v0[1]); w.y = cvt_pk_bf16(v0[2], v0[3]); w.z = cvt_pk_bf16(v1[0], v1[1]); w.w = cvt_pk_bf16(v1[2], v1[3]);
                        *(u32x4*)(mix + (size_t)row * D + 768 + bj * 128 + wc * 32 + fq * 8) = w;
                    }
                }
            }
    }
    DEV void skinny(f32x4 a0, f32x4 a1, LAS unsigned char* lds) const {
        EPI_IDS
        float q = ((a0[0] * a0[0] + a0[1] * a0[1]) + (a0[2] * a0[2] + a0[3] * a0[3])) + ((a1[0] * a1[0] + a1[1] * a1[1]) + (a1[2] * a1[2] + a1[3] * a1[3]));
        q += __shfl_xor(q, 16); q += __shfl_xor(q, 32);
        LAS float* ex = (LAS float*)(lds + LDS_EX);
        if (fq == 0) ex[fr * 8 + wid] = q;
        __syncthreads();
        if (fr == 0) {
            const f32x4 e0 = *(const LAS f32x4*)ex, e1 = *(const LAS f32x4*)(ex + 4);
            const float rs = rsqrtf((((e0[0] + e0[1]) + (e0[2] + e0[3])) + ((e1[0] + e1[1]) + (e1[2] + e1[3]))) * (1.0f / 256.0f) + EPS);
            bf16_t* mp = mix + (size_t)rowof(s, k1 + 16 * (L2 - 1)) * D + 768 + wid * 32 + fq * 4;
            const f32x4 v0 = a0 * rs, v1 = a1 * rs;
            *(u32x2*)mp = (u32x2){cvt_pk_bf16(v0[0], v0[1]), cvt_pk_bf16(v0[2], v0[3])};
            *(u32x2*)(mp + 16) = (u32x2){cvt_pk_bf16(v1[0], v1[1]), cvt_pk_bf16(v1[2], v1[3])};
        }
        __syncthreads();
    }
};


DEV void phase_prologue(const Params& p, LAS unsigned char* lds) {
    unsigned char* ws = p.ws;
    int tid = threadIdx.x; asm volatile("" : "+v"(tid));
    const long gt = (long)blockIdx.x * NT + tid, gs = (long)gridDim.x * NT;
    LAS float* ctab = (LAS float*)lds;
    if (tid < 64) ctab[tid] = cospif((float)tid * (1.0f / 32.0f));
    __syncthreads();
    bf16_t* W1 = (bf16_t*)(ws + WS_W1); bf16_t* W2 = (bf16_t*)(ws + WS_W2); bf16_t* W3 = (bf16_t*)(ws + WS_W3); bf16_t* W4 = (bf16_t*)(ws + WS_W4);
    LAS unsigned char* xl = lds + 1024;
#define XPOSE_STORE4(pieces, dst0, ldk) do { _Pragma("unroll") for (int _q = 0; _q < 4; ++_q) *(LAS u32x4*)(xl + _q * 9216 + ((tid & 63) * 9 + (tid >> 6)) * 16) = (pieces)[_q]; __syncthreads(); \
        const int _r = tid >> 3, _c = tid & 7; _Pragma("unroll") for (int _q = 0; _q < 4; ++_q) { const u32x4 _v = *(const LAS u32x4*)(xl + _q * 9216 + (_r * 9 + _c) * 16); \
        *(u32x4*)((dst0) + (size_t)(_q * 64 + _r) * (ldk) + _c * 8) = _v; } __syncthreads(); } while (0)
    const int nl = tid & 63, k8l = tid >> 6;
    for (int S = blockIdx.x; S < DEPTH * 16 * 6; S += gridDim.x) {
        const int nq = S % 6, kb = (S / 6) % 16, l = S / (6 * 16), k0 = kb * 64 + k8l * 8;
        float v[4][8];
#pragma unroll
        for (int j = 0; j < 8; ++j) { const int k = k0 + j; const float g = p.norm1_g[l * D + k]; const float* src = p.w_in + ((size_t)l * D + k) * NIN0 + nq * 256 + nl;
#pragma unroll
            for (int q = 0; q < 4; ++q) v[q][j] = src[q * 64] * g; }
        u32x4 pc[4];
#pragma unroll
        for (int q = 0; q < 4; ++q) pc[q] = pack8(v[q]);
        XPOSE_STORE4(pc, W1 + ((size_t)l * NZ + nq * 256) * D + kb * 64, D);
    }
    for (int S = blockIdx.x; S < DEPTH * 16 * 4; S += gridDim.x) {
        const int nq = S % 4, kb = (S / 4) % 16, l = S / (4 * 16), k0 = kb * 64 + k8l * 8;
        float v[4][8];
#pragma unroll
        for (int j = 0; j < 8; ++j) { const int k = k0 + j; const float g = p.mix_g[l * D + k]; const float* src = p.w_out + ((size_t)l * D + k) * D + nq * 256 + nl;
#pragma unroll
            for (int q = 0; q < 4; ++q) v[q][j] = src[q * 64] * g; }
        u32x4 pc[4];
#pragma unroll
        for (int q = 0; q < 4; ++q) pc[q] = pack8(v[q]);
        XPOSE_STORE4(pc, W2 + ((size_t)l * D + nq * 256) * D + kb * 64, D);
    }
    for (int S = blockIdx.x; S < DEPTH * 16 * 22; S += gridDim.x) {
        const int pn = S % 22, kb = (S / 22) % 16, l = S / (22 * 16), k0 = kb * 64 + k8l * 8;
        int col[4];
#pragma unroll
        for (int q = 0; q < 4; ++q) { const int rem = q * 64 + nl, bj = rem >> 7, wc = (rem >> 5) & 3, nn = (rem >> 4) & 1, i = rem & 15;
            const int d = pn * 128 + wc * 32 + (i >> 2) * 8 + bj * 4 + (i & 3); col[q] = nn ? DFF + d : d; }
        float v[4][8];
#pragma unroll
        for (int j = 0; j < 8; ++j) { const int k = k0 + j; const float g = p.norm2_g[l * D + k]; const float* src = p.w_gate_up + ((size_t)l * D + k) * NGU;
#pragma unroll
            for (int q = 0; q < 4; ++q) v[q][j] = src[col[q]] * g; }
        u32x4 pc[4];
#pragma unroll
        for (int q = 0; q < 4; ++q) pc[q] = pack8(v[q]);
        XPOSE_STORE4(pc, W3 + ((size_t)l * NGU + pn * 256) * D + kb * 64, D);
    }
    for (int S = blockIdx.x; S < DEPTH * 44 * 4; S += gridDim.x) {
        const int nq = S % 4, kb = (S / 4) % 44, l = S / (4 * 44), k0 = kb * 64 + k8l * 8;
        float v[4][8];
#pragma unroll
        for (int j = 0; j < 8; ++j) { const int k = k0 + j; const float* src = p.w_down + ((size_t)l * DFF + k) * D + nq * 256 + nl;
#pragma unroll
            for (int q = 0; q < 4; ++q) v[q][j] = src[q * 64]; }
        u32x4 pc[4];
#pragma unroll
        for (int q = 0; q < 4; ++q) pc[q] = pack8(v[q]);
        XPOSE_STORE4(pc, W4 + ((size_t)l * D + nq * 256) * DFF + kb * 64, DFF);
    }
#undef XPOSE_STORE4
    {
        float tt[64];
#pragma unroll
        for (int c = 0; c < 64; ++c) { const int jj = ((nl < 33 ? nl : nl - 32) * c) & 63; tt[c] = nl < 33 ? ctab[jj] : -ctab[(jj - 16) & 63]; }
        LAS float* sb = (LAS float*)(lds + 40960);
        for (int S = blockIdx.x; S < DEPTH * 16 * 4; S += gridDim.x) {
            const int hd = S % 4, kb = (S / 4) % 16, l = S / (4 * 16);
#pragma unroll
            for (int j = 0; j < 2; ++j) { const int k = (tid >> 4) + 32 * j, c4 = (tid & 15) * 4;
                *(LAS f32x4*)(sb + k * 64 + c4) = *(const f32x4*)(p.w_in + ((size_t)l * D + kb * 64 + k) * NIN0 + 1536 + hd * 64 + c4); }
            __syncthreads();
            float val[8];
#pragma unroll
            for (int j = 0; j < 8; ++j) {
                const int k = k8l * 8 + j;
                float a = 0.f;
#pragma unroll
                for (int c4 = 0; c4 < 64; c4 += 4) { const f32x4 x = *(const LAS f32x4*)(sb + k * 64 + c4);
#pragma unroll
                    for (int e = 0; e < 4; ++e) a += x[e] * tt[c4 + e]; }
                val[j] = a * p.norm1_g[l * D + kb * 64 + k];
            }
            *(LAS u32x4*)(xl + ((tid & 63) * 9 + (tid >> 6)) * 16) = pack8(val);
            __syncthreads();
            { const int r = tid >> 3, c = tid & 7;
              *(u32x4*)(W1 + ((size_t)l * NZ + 1536 + hd * 64 + r) * D + kb * 64 + c * 8) = *(const LAS u32x4*)(xl + (r * 9 + c) * 16); }
            __syncthreads();
        }
    }
    bf16_t* PW = (bf16_t*)(ws + WS_PW);
    for (long i = gt; i < (long)DEPTH * 4 * 96 * 96; i += gs) {
        const int k = (int)(i % 96), n = (int)((i / 96) % 96), lg = (int)(i / (96 * 96)), l = lg >> 2, g = lg & 3;
        const float v = p.pool_w[((size_t)lg * 96 + k) * 96 + n] * p.pool_scale[l * 384 + g * 96 + n];
        PW[i] = (bf16_t)(cvt_pk_bf16(v, 0.f) & 0xffff);
    }
    bf16_t* DPm = (bf16_t*)(ws + WS_DP); bf16_t* DSm = (bf16_t*)(ws + WS_DS);
    for (long i = gt; i < (long)MPP * KP; i += gs) {
        const int kk = (int)(i % KP), k2 = (int)(i / KP), part = kk / KHP, n2 = kk % KHP;
        float v = 0.f;
        if (k2 < L2P && n2 < L2P) { const float a = (float)(2 * ((k2 * n2) % L2P)) * (1.0f / (float)L2P); v = part == 0 ? cospif(a) : sinpif(a); }
        DPm[i] = (bf16_t)(cvt_pk_bf16(v, 0.f) & 0xffff);
    }
    for (long i = gt; i < (long)MPS * KS; i += gs) {
        const int kk = (int)(i % KS), k2 = (int)(i / KS), part = kk / KHS, n2 = kk % KHS;
        float v = 0.f;
        if (k2 < L2S && n2 < L2S) { const float a = (float)(2 * ((k2 * n2) % L2S)) * (1.0f / (float)L2S); v = part == 0 ? cospif(a) : sinpif(a); }
        DSm[i] = (bf16_t)(cvt_pk_bf16(v, 0.f) & 0xffff);
    }
    f32x2* TWPt = (f32x2*)(ws + WS_TWP); f32x2* TWSt = (f32x2*)(ws + WS_TWS);
    for (long i = gt; i < 16 * KHP; i += gs) {
        const int n2 = (int)(i % KHP), k1 = (int)(i / KHP);
        const float a = (float)(2 * ((k1 * n2) % LP)) * (1.0f / (float)LP), sc = 1.0f / sqrtf(64.0f * (float)LP);
        TWPt[i] = (f32x2){cospif(a) * sc, -sinpif(a) * sc};
    }
    for (long i = gt; i < 16 * KHS; i += gs) {
        const int n2 = (int)(i % KHS), k1 = (int)(i / KHS);
        const float a = (float)(2 * ((k1 * n2) % LS)) * (1.0f / (float)LS), sc = 1.0f / sqrtf(64.0f * (float)LS);
        TWSt[i] = (f32x2){cospif(a) * sc, -sinpif(a) * sc};
    }
    bf16_t* hb = (bf16_t*)(ws + WS_HB); float* ss1 = (float*)(ws + WS_SS1);
    const int lane = tid & 63, gw = (int)(gt >> 6), nw = (int)(gs >> 6);
    for (int r0 = gw * 4; r0 < T; r0 += nw * 4) {
        f32x4 v[4][4];
#pragma unroll
        for (int q = 0; q < 4; ++q) {
            const int r = r0 + q;
            const float* src = r < 16384 ? p.x_prompt + (size_t)r * D : (r < TX ? p.x_sample + (size_t)(r - 16384) * D : p.meta + (size_t)((r - TX) & 15) * D);
#pragma unroll
            for (int j = 0; j < 4; ++j) v[q][j] = __builtin_nontemporal_load((const f32x4*)(src + j * 256 + lane * 4));
        }
        float s[4];
#pragma unroll
        for (int q = 0; q < 4; ++q) {
            s[q] = 0.f;
#pragma unroll
            for (int j = 0; j < 4; ++j) {
                const f32x4 x = v[q][j];
                u32x2 w; w.x = cvt_pk_bf16(x[0], x[1]); w.y = cvt_pk_bf16(x[2], x[3]);
                *(u32x2*)(hb + (size_t)(r0 + q) * D + j * 256 + lane * 4) = w;
                s[q] += (x[0] * x[0] + x[1] * x[1]) + (x[2] * x[2] + x[3] * x[3]);
            }
        }
#pragma unroll
        for (int o = 32; o >= 1; o >>= 1)
#pragma unroll
            for (int q = 0; q < 4; ++q) s[q] += __shfl_xor(s[q], o);
        if (lane < 4) { const float sv = lane == 0 ? s[0] : (lane == 1 ? s[1] : (lane == 2 ? s[2] : s[3])); *(f32x4*)(ss1 + (size_t)(r0 + lane) * 4) = (f32x4){sv, 0.f, 0.f, 0.f}; }
    }
}

DEV void phase_xb(const Params& p, int it0, int itstep);
DEV void phase_gemm1(const Params& p, int l, LAS unsigned char* lds) {
    unsigned char* ws = p.ws;
    unsigned* vcnt = (unsigned*)(ws + WS_BAR) + VCNT_WORD0 + 64 * l;
    Epi1 e{(bf16_t*)(ws + WS_Z), (const float*)(ws + WS_SS1), vcnt};
    const bf16_t* A = (const bf16_t*)(ws + WS_HB); const bf16_t* B = (const bf16_t*)(ws + WS_W1) + (size_t)l * NZ * D;
    const int G = gridDim.x, b = blockIdx.x;
    const bool tail = (G == 256) ? (b >= 64) : true;
    if (G == 256) { if (b >= 136 && b < 199) { const int i = b - 136; skinny_item(lds, A, D, B, D, D, i % 9, 6 - i / 9, e); } }
    else for (int i = b; i < 9 * 7; i += G) skinny_item(lds, A, D, B, D, D, i % 9, 6 - i / 9, e);
    gemm_loop<0>(lds, A, D, B, D, D, e, b, G, 192 * 7, TileG1{});
    if (tail) {
        int tid = threadIdx.x; asm volatile("" : "+v"(tid));
        if (tid == 0) { unsigned sp = 0; while (__hip_atomic_load(vcnt, __ATOMIC_RELAXED, __HIP_MEMORY_SCOPE_AGENT) < (unsigned)NVTILES) { __builtin_amdgcn_s_sleep(1); if (++sp > (1u << 22)) break; } }
        __syncthreads();
        __builtin_amdgcn_fence(__ATOMIC_ACQUIRE, "agent");
        asm volatile("s_waitcnt vmcnt(0)" ::: "memory");
        if (G == 256) phase_xb(p, b - 64, 192); else phase_xb(p, b, G);
    }
}
DEV void phase_gemm2(const Params& p, int l, LAS unsigned char* lds) {
    unsigned char* ws = p.ws;
    EpiRes e{(bf16_t*)(ws + WS_HB), (float*)(ws + WS_SS2)};
    const bf16_t* A = (const bf16_t*)(ws + WS_MIX); const bf16_t* B = (const bf16_t*)(ws + WS_W2) + (size_t)l * D * D;
    if (l < DEPTH - 1) for (int i = blockIdx.x; i < 9 * 4; i += gridDim.x) skinny_item(lds, A, D, B, D, D, i % 9, i / 9, e);
    gemm_loop<0>(lds, A, D, B, D, D, e, blockIdx.x, gridDim.x, 192 * 4, TileMap{192, 4});
}
DEV void phase_gemm3(const Params& p, int l, LAS unsigned char* lds) {
    unsigned char* ws = p.ws;
    unsigned* mcnt = (unsigned*)(ws + WS_BAR) + MCNT_WORD0 + 64 * l;
    Epi3 e{(bf16_t*)(ws + WS_ACT), (const float*)(ws + WS_SS2), mcnt};
    const bf16_t* A = (const bf16_t*)(ws + WS_HB); const bf16_t* B = (const bf16_t*)(ws + WS_W3) + (size_t)l * NGU * D;
    const int G = gridDim.x, b = blockIdx.x;
    if (l == DEPTH - 1) {}
    else if (G == 256) { if (b >= 128) for (int i = b - 128; i < 9 * 22; i += 128) skinny_item(lds, A, D, B, D, D, i % 9, i / 9, e); }
    else for (int i = b; i < 9 * 22; i += G) skinny_item(lds, A, D, B, D, D, i % 9, i / 9, e);
    gemm_loop<0>(lds, A, D, B, D, D, e, b, G, 192 * 22, TileMap{192, 22});
    if (l < DEPTH - 1 && G == 256 && b >= 220) {
        int tid = threadIdx.x; asm volatile("" : "+v"(tid));
        if (tid == 0) { unsigned sp = 0; while (__hip_atomic_load(mcnt, __ATOMIC_RELAXED, __HIP_MEMORY_SCOPE_AGENT) < 198u) { __builtin_amdgcn_s_sleep(1); if (++sp > (1u << 22)) break; } }
        __syncthreads();
        __builtin_amdgcn_fence(__ATOMIC_ACQUIRE, "agent");
        asm volatile("s_waitcnt vmcnt(0)" ::: "memory");
        EpiRes e4{(bf16_t*)(ws + WS_HB), (float*)(ws + WS_SS1)};
        const int i = b - 220;
        skinny_item(lds, (const bf16_t*)(ws + WS_ACT), DFF, (const bf16_t*)(ws + WS_W4) + (size_t)l * D * DFF, DFF, DFF, i % 9, i / 9, e4);
    }
}
DEV void phase_gemm4(const Params& p, int l, LAS unsigned char* lds) {
    unsigned char* ws = p.ws;
    EpiRes e{(bf16_t*)(ws + WS_HB), (float*)(ws + WS_SS1)};
    const bf16_t* A = (const bf16_t*)(ws + WS_ACT); const bf16_t* B = (const bf16_t*)(ws + WS_W4) + (size_t)l * D * DFF;
    if (l < DEPTH - 1 && gridDim.x != 256) for (int i = blockIdx.x; i < 9 * 4; i += gridDim.x) skinny_item(lds, A, DFF, B, DFF, DFF, i % 9, i / 9, e);
    gemm_loop<0>(lds, A, DFF, B, DFF, DFF, e, blockIdx.x, gridDim.x, 192 * 4, TileMapRev{192, 4});
}
DEV void dft_item(const Params& p, int it, LAS unsigned char* lds) {
    unsigned char* ws = p.ws;
    bf16_t* mix = (bf16_t*)(ws + WS_MIX);
    const bf16_t* wbp = (const bf16_t*)((unsigned char*)p.out + OUT_WBP); const bf16_t* wbs = (const bf16_t*)((unsigned char*)p.out + OUT_WBS);
    if (it < 64) {
        const int pm = it & 3, pn = it >> 2;
        EpiF e{mix, 0, pn, L2P};
        gemm_loop<1>(lds, (const bf16_t*)(ws + WS_DP), KP, wbp, NCP, KP, e, 0, 1, 1, TileOne{pm * 256, pn * 256});
    } else if (it < 192) {
        const int pn = it - 64;
        EpiF e{mix, 1 + (pn >> 4), pn & 15, L2S};
        gemm_loop<1>(lds, (const bf16_t*)(ws + WS_DS), KS, wbs, NCS, KS, e, 0, 1, 1, TileOne{0, pn * 256});
    } else if (it < 208) {
        const int pn = it - 192;
        EpiF e{mix, 0, pn, L2P};
        skinny_dft(lds, (const bf16_t*)(ws + WS_DP), KP, wbp, NCP, KP, L2P - 1, pn * 256, e);
    } else {
        const int pn = it - 208;
        EpiF e{mix, 1 + (pn >> 4), pn & 15, L2S};
        skinny_dft(lds, (const bf16_t*)(ws + WS_DS), KS, wbs, NCS, KS, L2S - 1, pn * 256, e);
    }
}
DEV void phase_dft(const Params& p, LAS unsigned char* lds) {
    const int b = blockIdx.x, G = gridDim.x;
    if (G == 256) {
        if (b < 192) dft_item(p, b, lds);
        else for (int it = b; it < 336; it += 64) dft_item(p, it, lds);
    } else {
        for (int it = b; it < 336; it += G) dft_item(p, it, lds);
    }
}

struct XaTile { int s, p0, np, L; };
DEV XaTile xa_next(int& g0, int g1) {
    XaTile t; t.s = 0; t.p0 = 0; t.np = 0; t.L = 16;
    if (g0 < g1) {
        int gs, gl;
        if (g0 < 1025) { t.s = 0; gs = 0; gl = 1025; } else { const int q = (g0 - 1025) / 257; t.s = 1 + q; gs = 1025 + 257 * q; gl = 257; }
        const int ng = min(4, min(g1, gs + gl) - g0);
        t.p0 = (g0 - gs) * 16; t.np = ng * 16; t.L = gl * 16; g0 += ng;
    }
    return t;
}
DEV void xa_stage_load(const bf16_t* z, const XaTile& t, int tid, u32x4 (&v)[8]) {
    const int nchunk = (t.np + 15) * 48;
#pragma unroll
    for (int j = 0; j < 8; ++j) {
        const int c = tid + j * NT, i = c / 48, cg8 = c % 48, pp = t.p0 - 8 + i;
        v[j] = (u32x4){0u, 0u, 0u, 0u};
        if (t.np > 0 && c < nchunk && pp >= 0 && pp < t.L) v[j] = *(const u32x4*)(z + (size_t)rowof(t.s, pp) * NZ + 1152 + cg8 * 8);
    }
}
struct ConvRegs { u32x4 xa[6], gc[6], gb[4]; };
DEV void xa_conv_load(const bf16_t* z, const XaTile& t, int tb, int lane, ConvRegs& r, int (&rows)[6]) {
#pragma unroll
    for (int i = 0; i < 6; ++i) { const int pp = t.p0 + tb - 1 + i; rows[i] = rowof(t.s, min(max(pp, 0), t.L - 1)); }
    if (tb < t.np && lane < 48) {
        const int c = lane * 8;
#pragma unroll
        for (int i = 0; i < 6; ++i) { const bf16_t* q = z + (size_t)rows[i] * NZ + c; r.xa[i] = *(const u32x4*)q; r.gc[i] = *(const u32x4*)(q + 768); }
#pragma unroll
        for (int k = 0; k < 4; ++k) r.gb[k] = *(const u32x4*)(z + (size_t)rows[k + 1] * NZ + c + 384);
    }
}
DEV void xa_conv_finish(bf16_t* mix, const float* cw, const XaTile& t, int tb, int lane, const ConvRegs& r, const int (&rows)[6]) {
    if (tb >= t.np) return;
    float a[4][8]; float sq[4] = {0.f, 0.f, 0.f, 0.f};
    if (lane < 48) {
        const int c = lane * 8;
        float wv[3][8];
#pragma unroll
        for (int q = 0; q < 3; ++q) { const f32x4 w0 = *(const f32x4*)(cw + q * 384 + c), w1 = *(const f32x4*)(cw + q * 384 + c + 4);
#pragma unroll
            for (int j = 0; j < 4; ++j) { wv[q][j] = w0[j]; wv[q][4 + j] = w1[j]; } }
        float y[6][8];
#pragma unroll
        for (int i = 0; i < 6; ++i) {
            const int pp = t.p0 + tb - 1 + i;
            const float msk = (pp >= 0 && pp < t.L) ? 1.0f : 0.0f;
#pragma unroll
            for (int j = 0; j < 4; ++j) { y[i][2 * j] = bflo(r.xa[i][j]) * bflo(r.gc[i][j]) * msk; y[i][2 * j + 1] = bfhi(r.xa[i][j]) * bfhi(r.gc[i][j]) * msk; }
        }
#pragma unroll
        for (int k = 0; k < 4; ++k)
#pragma unroll
            for (int j = 0; j < 4; ++j) {
                const int e0 = 2 * j, e1 = 2 * j + 1;
                a[k][e0] = bflo(r.gb[k][j]) * (wv[0][e0] * y[k][e0] + wv[1][e0] * y[k + 1][e0] + wv[2][e0] * y[k + 2][e0]);
                a[k][e1] = bfhi(r.gb[k][j]) * (wv[0][e1] * y[k][e1] + wv[1][e1] * y[k + 1][e1] + wv[2][e1] * y[k + 2][e1]);
                sq[k] += a[k][e0] * a[k][e0] + a[k][e1] * a[k][e1];
            }
    } else {
#pragma unroll
        for (int k = 0; k < 4; ++k)
#pragma unroll
            for (int j = 0; j < 8; ++j) a[k][j] = 0.f;
    }
#pragma unroll
    for (int o = 32; o >= 1; o >>= 1)
#pragma unroll
        for (int k = 0; k < 4; ++k) sq[k] += __shfl_xor(sq[k], o);
    if (lane < 48) {
#pragma unroll
        for (int k = 0; k < 4; ++k) {
            const float rs = rsqrtf(sq[k] * (1.0f / 384.0f) + EPS);
#pragma unroll
            for (int j = 0; j < 8; ++j) a[k][j] *= rs;
            *(u32x4*)(mix + (size_t)rows[k + 1] * D + lane * 8) = pack8(a[k]);
        }
    }
}
DEV void lds_row_add(const LAS bf16_t* q, float (&S)[8], float sign) {
    const u32x4 v = *(const LAS u32x4*)q;
#pragma unroll
    for (int j = 0; j < 4; ++j) { S[2 * j] += sign * bflo(v[j]); S[2 * j + 1] += sign * bfhi(v[j]); }
}
#define XA_BAR do { asm volatile("s_waitcnt lgkmcnt(0)" ::: "memory"); __builtin_amdgcn_s_barrier(); } while (0)

DEV void xa_tile(const Params& p, int l, const XaTile& t, const XaTile& tn, u32x4 (&st)[8], LAS unsigned char* lds, const bf16x8 (&bfr)[3][3]) {
    unsigned char* ws = p.ws;
    const bf16_t* z = (const bf16_t*)(ws + WS_Z); bf16_t* mix = (bf16_t*)(ws + WS_MIX);
    const float* cw = p.conv_w + (size_t)l * 3 * 384;
    int tid = threadIdx.x; asm volatile("" : "+v"(tid));
    const int wid = tid >> 6, lane = tid & 63, fr = lane & 15, fq = lane >> 4;
    LAS bf16_t* xs = (LAS bf16_t*)lds;
    LAS bf16_t* pre = (LAS bf16_t*)(lds + 80 * 784);
    LAS float* psum = (LAS float*)(lds + 80 * 784 + 64 * 784);
    const int np = t.np, p0 = t.p0, L = t.L, nchunk = (np + 15) * 48;
    ConvRegs cr; int rows[6];
    xa_conv_load(z, t, wid * 8, lane, cr, rows);
#pragma unroll
    for (int j = 0; j < 8; ++j) { const int c = tid + j * NT, i = c / 48, cg8 = c % 48; if (c < nchunk) *(LAS u32x4*)(xs + i * 392 + cg8 * 8) = st[j]; }
    xa_stage_load(z, tn, tid, st);
    XA_BAR;
    if (tid < 384) {
        const int cg8 = tid % 48, seg = tid / 48, gi = cg8 / 12, left = 1 << gi, right = left - 1, t0 = seg * 8;
        if (t0 < np) {
            const LAS bf16_t* col = xs + cg8 * 8;
            float S[8];
#pragma unroll
            for (int j = 0; j < 8; ++j) S[j] = 0.f;
            for (int q = t0 + 8 - left; q <= t0 + 8 + right; ++q) lds_row_add(col + q * 392, S, 1.0f);
#pragma unroll
            for (int k = 0; k < 8; ++k) {
                const int tt = t0 + k, i = tt + 8, pp = p0 + tt;
                const float inv = 1.0f / (float)(min(pp + right, L - 1) - max(pp - left, 0) + 1);
                float o[8];
#pragma unroll
                for (int j = 0; j < 8; ++j) o[j] = S[j] * inv;
                lds_row_add(col + i * 392, o, -1.0f);
                *(LAS u32x4*)(pre + tt * 392 + cg8 * 8) = pack8(o);
                if (k < 7) { lds_row_add(col + (i + right + 1) * 392, S, 1.0f); lds_row_add(col + (i - left) * 392, S, -1.0f); }
            }
        }
    }
    xa_conv_finish(mix, cw, t, wid * 8, lane, cr, rows);
    xa_conv_load(z, t, wid * 8 + 4, lane, cr, rows);
    XA_BAR;
    const int g = wid >> 1, nbh = wid & 1, nmb = np >> 4;
    f32x4 pacc[4][3];
#pragma unroll
    for (int mb = 0; mb < 4; ++mb)
#pragma unroll
        for (int nb = 0; nb < 3; ++nb) pacc[mb][nb] = (f32x4){0.f, 0.f, 0.f, 0.f};
#pragma unroll
    for (int mb = 0; mb < 4; ++mb) {
        if (mb < nmb) {
#pragma unroll
            for (int ks = 0; ks < 3; ++ks) {
                const bf16x8 af = *(const LAS bf16x8*)(pre + (mb * 16 + fr) * 392 + g * 96 + ks * 32 + fq * 8);
#pragma unroll
                for (int nb = 0; nb < 3; ++nb) pacc[mb][nb] = __builtin_amdgcn_mfma_f32_16x16x32_bf16(bfr[nb][ks], af, pacc[mb][nb], 0, 0, 0);
            }
            float q = 0.f;
#pragma unroll
            for (int nb = 0; nb < 3; ++nb) { const f32x4 v = pacc[mb][nb]; q += (v[0] * v[0] + v[1] * v[1]) + (v[2] * v[2] + v[3] * v[3]); }
            q += __shfl_xor(q, 16); q += __shfl_xor(q, 32);
            if (fq == 0) psum[(mb * 16 + fr) * 8 + wid] = q;
        }
    }
    XA_BAR;
#pragma unroll
    for (int mb = 0; mb < 4; ++mb) {
        if (mb < nmb) {
            const f32x4 e0 = *(const LAS f32x4*)(psum + (mb * 16 + fr) * 8), e1 = *(const LAS f32x4*)(psum + (mb * 16 + fr) * 8 + 4);
            const float rs = rsqrtf((((e0[0] + e0[1]) + (e0[2] + e0[3])) + ((e1[0] + e1[1]) + (e1[2] + e1[3]))) * (1.0f / 384.0f) + EPS);
            const int row = rowof(t.s, p0 + mb * 16 + fr);
#pragma unroll
            for (int nb = 0; nb < 3; ++nb) {
                const f32x4 v = pacc[mb][nb] * rs;
                u32x2 w; w.x = cvt_pk_bf16(v[0], v[1]); w.y = cvt_pk_bf16(v[2], v[3]);
                *(u32x2*)(mix + (size_t)row * D + 384 + g * 96 + (nbh * 3 + nb) * 16 + fq * 4) = w;
            }
        }
    }
    xa_conv_finish(mix, cw, t, wid * 8 + 4, lane, cr, rows);
    XA_BAR;
}

DEV void phase_xa(const Params& p, int l, LAS unsigned char* lds) {
    int g0, g1;
    if (gridDim.x == 256) {
        const int b = blockIdx.x, b1 = b + 1;
        const int c0 = b < 64 ? 60 * b : (b < 192 ? 3840 + 140 * (b - 64) : 21760 + 143 * (b - 192));
        const int c1 = b1 < 64 ? 60 * b1 : (b1 < 192 ? 3840 + 140 * (b1 - 64) : 21760 + 143 * (b1 - 192));
        g0 = (int)((long)c0 * NGROUPS / 30912); g1 = (int)((long)c1 * NGROUPS / 30912);
    } else { g0 = (int)((long)blockIdx.x * NGROUPS / gridDim.x); g1 = (int)((long)(blockIdx.x + 1) * NGROUPS / gridDim.x); }
    int tid = threadIdx.x; asm volatile("" : "+v"(tid));
    bf16x8 bfr[3][3];
    {
        const int wid = tid >> 6, lane = tid & 63, fr = lane & 15, fq = lane >> 4, g = wid >> 1, nbh = wid & 1;
        const bf16_t* pw = (const bf16_t*)(p.ws + WS_PW) + (size_t)l * 4 * 96 * 96;
#pragma unroll
        for (int nb = 0; nb < 3; ++nb)
#pragma unroll
            for (int ks = 0; ks < 3; ++ks) bfr[nb][ks] = *(const bf16x8*)(pw + ((size_t)g * 96 + (nbh * 3 + nb) * 16 + fr) * 96 + ks * 32 + fq * 8);
    }
    const bf16_t* z = (const bf16_t*)(p.ws + WS_Z);
    XaTile t = xa_next(g0, g1);
    u32x4 st[8];
    xa_stage_load(z, t, tid, st);
    while (t.np > 0) {
        const XaTile tn = xa_next(g0, g1);
        xa_tile(p, l, t, tn, st, lds, bfr);
        t = tn;
    }
    asm volatile("s_waitcnt vmcnt(0)" ::: "memory");
    __syncthreads();
}

DEV void dft4(float& ar, float& ai, float& br, float& bi, float& cr, float& ci, float& dr, float& di) {
    const float s0r = ar + cr, s0i = ai + ci, d0r = ar - cr, d0i = ai - ci;
    const float s1r = br + dr, s1i = bi + di, d1r = br - dr, d1i = bi - di;
    ar = s0r + s1r; ai = s0i + s1i; cr = s0r - s1r; ci = s0i - s1i;
    br = d0r + d1i; bi = d0i - d1r; dr = d0r - d1i; di = d0i + d1r;
}
DEV void cmulc(float& r, float& i, float c, float s) { const float tr = r * c - i * s, ti = r * s + i * c; r = tr; i = ti; }

DEV void phase_xb(const Params& p, int it0, int itstep) {
    unsigned char* ws = p.ws;
    const bf16_t* z = (const bf16_t*)(ws + WS_Z);
    int tid = threadIdx.x; asm volatile("" : "+v"(tid));
    const int m = tid & 255, half = tid >> 8;
    const int hdc = 1536 + (m >> 6) * 64, ml = m & 63;
    const int cre = hdc + (ml <= 32 ? ml : 64 - ml);
    const int cim = hdc + 32 + ((ml & 31) == 0 ? 1 : (ml < 32 ? ml : 64 - ml));
    const float sgn = (ml & 31) == 0 ? 0.f : (ml < 32 ? 1.f : -1.f);
    for (int it = it0; it < 136 + 8 * 40; it += itstep) {
        int s, gq, L2, KH, N, colbase; const f32x2* tw; bf16_t* wb;
        if (it < 136) { s = 0; gq = it; L2 = L2P; KH = KHP; N = NCP; colbase = 0; tw = (const f32x2*)(ws + WS_TWP); wb = (bf16_t*)((unsigned char*)p.out + OUT_WBP); }
        else { const int j = it - 136; s = 1 + j / 40; gq = j % 40; L2 = L2S; KH = KHS; N = NCS; colbase = (s - 1) * 4096; tw = (const f32x2*)(ws + WS_TWS); wb = (bf16_t*)((unsigned char*)p.out + OUT_WBS); }
        unsigned outr[16][2], outi[16][2];
        bf16_t raw[2][32];
#define XB_LOAD(set, idx) do { const int _n2 = 8 * gq + 4 * half + (idx); \
            if (_n2 < L2) { _Pragma("unroll") for (int n1 = 0; n1 < 16; ++n1) { const bf16_t* q = z + (size_t)rowof(s, L2 * n1 + _n2) * NZ; raw[set][2 * n1] = q[cre]; raw[set][2 * n1 + 1] = q[cim]; } } \
            else { _Pragma("unroll") for (int n1 = 0; n1 < 32; ++n1) raw[set][n1] = 0; } } while (0)
        XB_LOAD(0, 0);
        float pr[2][16], pi[2][16];
#pragma unroll
        for (int idx = 0; idx < 4; ++idx) {
            const int i2 = idx >> 1, i1 = idx & 1, set = idx & 1;
            if (idx < 3) XB_LOAD(set ^ 1, idx + 1);
            SCHED;
            {
                const int n2 = 8 * gq + 4 * half + idx;
                float xr[16], xi[16];
                if (n2 < L2) {
#pragma unroll
                    for (int n1 = 0; n1 < 16; ++n1) { xr[n1] = bf2f(raw[set][2 * n1]); xi[n1] = bf2f(raw[set][2 * n1 + 1]) * sgn; }
#pragma unroll
                    for (int b = 0; b < 4; ++b) dft4(xr[b], xi[b], xr[4 + b], xi[4 + b], xr[8 + b], xi[8 + b], xr[12 + b], xi[12 + b]);
                    const float C1 = 0.92387953251128674f, S1 = 0.38268343236508977f, R2 = 0.70710678118654752f;
                    cmulc(xr[5], xi[5], C1, -S1);
                    cmulc(xr[6], xi[6], R2, -R2);
                    cmulc(xr[7], xi[7], S1, -C1);
                    cmulc(xr[9], xi[9], R2, -R2);
                    cmulc(xr[10], xi[10], 0.f, -1.f);
                    cmulc(xr[11], xi[11], -R2, -R2);
                    cmulc(xr[13], xi[13], S1, -C1);
                    cmulc(xr[14], xi[14], -R2, -R2);
                    cmulc(xr[15], xi[15], -C1, S1);
#pragma unroll
                    for (int c = 0; c < 4; ++c) dft4(xr[4 * c], xi[4 * c], xr[4 * c + 1], xi[4 * c + 1], xr[4 * c + 2], xi[4 * c + 2], xr[4 * c + 3], xi[4 * c + 3]);
#pragma unroll
                    for (int c = 0; c < 4; ++c)
#pragma unroll
                        for (int d = 0; d < 4; ++d) {
                            const int k1 = c + 4 * d;
                            const f32x2 t2 = tw[k1 * KH + n2];
                            const float r = xr[4 * c + d], i = xi[4 * c + d];
                            pr[i1][k1] = r * t2[0] - i * t2[1]; pi[i1][k1] = r * t2[1] + i * t2[0];
                        }
                } else {
#pragma unroll
                    for (int k1 = 0; k1 < 16; ++k1) { pr[i1][k1] = 0.f; pi[i1][k1] = 0.f; }
                }
            }
            if (i1 == 1) {
#pragma unroll
                for (int k1 = 0; k1 < 16; ++k1) { outr[k1][i2] = cvt_pk_bf16(pr[0][k1], pr[1][k1]); outi[k1][i2] = cvt_pk_bf16(pi[0][k1], pi[1][k1]); }
            }
        }
#undef XB_LOAD
#pragma unroll
        for (int k1 = 0; k1 < 16; ++k1) {
            const size_t col = (size_t)colbase + k1 * 256 + m;
            *(u32x2*)(wb + ((size_t)gq * N + col) * 8 + half * 4) = (u32x2){outr[k1][0], outr[k1][1]};
            *(u32x2*)(wb + ((size_t)(KH / 8 + gq) * N + col) * 8 + half * 4) = (u32x2){outi[k1][0], outi[k1][1]};
        }
    }
}

DEV void phase_final(const Params& p) {
    const float* ss = (const float*)(p.ws + WS_SS1);
    const bf16_t* hb = (const bf16_t*)(p.ws + WS_HB);
    int tid = threadIdx.x; asm volatile("" : "+v"(tid));
    const int lane = tid & 63;
    const int gw = (int)(((long)blockIdx.x * NT + tid) >> 6), nw = (int)(((long)gridDim.x * NT) >> 6);
    const f32x4 g00 = *(const f32x4*)(p.final_g + lane * 8), g01 = *(const f32x4*)(p.final_g + lane * 8 + 4);
    const f32x4 g10 = *(const f32x4*)(p.final_g + 512 + lane * 8), g11 = *(const f32x4*)(p.final_g + 512 + lane * 8 + 4);
    for (int r0 = gw * 2; r0 < TX; r0 += nw * 2) {
        u32x4 h[2][2]; float rs[2];
#pragma unroll
        for (int q = 0; q < 2; ++q) {
            rs[q] = row_rs(ss, r0 + q);
#pragma unroll
            for (int j = 0; j < 2; ++j) h[q][j] = __builtin_nontemporal_load((const u32x4*)(hb + (size_t)(r0 + q) * D + j * 512 + lane * 8));
        }
#pragma unroll
        for (int q = 0; q < 2; ++q) {
            float* o = p.out + (size_t)(r0 + q) * D + lane * 8;
            const float s0 = rs[q];
            __builtin_nontemporal_store((f32x4){bflo(h[q][0].x) * s0 * g00[0], bfhi(h[q][0].x) * s0 * g00[1], bflo(h[q][0].y) * s0 * g00[2], bfhi(h[q][0].y) * s0 * g00[3]}, (f32x4*)(o));
            __builtin_nontemporal_store((f32x4){bflo(h[q][0].z) * s0 * g01[0], bfhi(h[q][0].z) * s0 * g01[1], bflo(h[q][0].w) * s0 * g01[2], bfhi(h[q][0].w) * s0 * g01[3]}, (f32x4*)(o + 4));
            __builtin_nontemporal_store((f32x4){bflo(h[q][1].x) * s0 * g10[0], bfhi(h[q][1].x) * s0 * g10[1], bflo(h[q][1].y) * s0 * g10[2], bfhi(h[q][1].y) * s0 * g10[3]}, (f32x4*)(o + 512));
            __builtin_nontemporal_store((f32x4){bflo(h[q][1].z) * s0 * g11[0], bfhi(h[q][1].z) * s0 * g11[1], bflo(h[q][1].w) * s0 * g11[2], bfhi(h[q][1].w) * s0 * g11[3]}, (f32x4*)(o + 516));
        }
    }
}

#define XB_TMO      128
#define XB_XCNT(j)  (256  + 64 * (j))
#define XB_XSUB(j)  (1280 + 64 * (j))
#define XB_XGEN(j)  (2304 + 64 * (j))
#define XB_TOP      3328
#define XB_TOPGEN   3392
#define XCD_BAR_WORDS 3456
#define XB_SPIN_CAP (1u << 18)
DEV unsigned xb_ld(unsigned* p) { return __hip_atomic_load(p, __ATOMIC_RELAXED, __HIP_MEMORY_SCOPE_AGENT); }
DEV unsigned xb_add(unsigned* p, unsigned v) { return __hip_atomic_fetch_add(p, v, __ATOMIC_RELAXED, __HIP_MEMORY_SCOPE_AGENT); }
DEV unsigned xb_xcc_id() { return (unsigned)__builtin_amdgcn_s_getreg((3 << 11) | 20) & 0xFu; }
#define XB_SPIN(cond, bar) do { unsigned _sp = 0; while (cond) { __builtin_amdgcn_s_sleep(1); \
    if ((++_sp & 255u) == 0u) { if (xb_ld(&(bar)[XB_TMO])) break; if (_sp > XB_SPIN_CAP) { atomicAdd(&(bar)[XB_TMO], 1u); break; } } } } while (0)
struct XcdBarrier { unsigned* bar; unsigned x; volatile LAS unsigned* st; };
DEV XcdBarrier xcd_barrier_post(unsigned* bar, volatile LAS unsigned* st) {
    XcdBarrier b; b.bar = bar; b.x = xb_xcc_id(); b.st = st;
    if (threadIdx.x == 0) (void)xb_add(&bar[XB_XCNT(b.x)], 1u);
    return b;
}
DEV void xcd_barrier_complete(unsigned* bar, unsigned x, unsigned& nloc, unsigned& nx) {
    const unsigned G = gridDim.x * gridDim.y * gridDim.z;
    unsigned sum, cnt, mine, sp = 0u;
    for (;;) {
        sum = 0u; cnt = 0u; mine = 0u;
#pragma unroll
        for (unsigned j = 0; j < 16; ++j) { const unsigned c = xb_ld(&bar[XB_XCNT(j)]); sum += c; cnt += (c > 0u) ? 1u : 0u; mine = (j == x) ? c : mine; }
        if (sum == G) break;
        __builtin_amdgcn_s_sleep(1);
        if ((++sp & 255u) == 0u) { if (xb_ld(&bar[XB_TMO])) break; if (sp > XB_SPIN_CAP) { atomicAdd(&bar[XB_TMO], 1u); break; } }
    }
    nloc = mine > 0u ? mine : 1u; nx = cnt > 0u ? cnt : 1u;
}
DEV void xcd_barrier(const XcdBarrier& b) {
    asm volatile("s_waitcnt vmcnt(0)" ::: "memory");
    __syncthreads();
    if (threadIdx.x == 0) {
        unsigned* bar = b.bar;
        __builtin_amdgcn_s_waitcnt(0);
        unsigned nloc = b.st[0], nx = b.st[1];
        if (nloc == 0u) { xcd_barrier_complete(bar, b.x, nloc, nx); b.st[0] = nloc; b.st[1] = nx; }
        const unsigned old = xb_add(&bar[XB_XSUB(b.x)], 1u);
        const unsigned gen = old / nloc;
        if (old + 1u == (gen + 1u) * nloc) {
            __builtin_amdgcn_fence(__ATOMIC_RELEASE, "agent");
            asm volatile("s_waitcnt vmcnt(0)" ::: "memory");
            const unsigned og = xb_add(&bar[XB_TOP], 1u);
            const unsigned tg = og / nx;
            if (og + 1u == (tg + 1u) * nx) xb_add(&bar[XB_TOPGEN], 1u);
            else XB_SPIN(xb_ld(&bar[XB_TOPGEN]) == tg, bar);
            __builtin_amdgcn_fence(__ATOMIC_ACQUIRE, "agent");
            xb_add(&bar[XB_XGEN(b.x)], 1u);
            asm volatile("s_waitcnt vmcnt(0)" ::: "memory");
        } else {
            XB_SPIN(xb_ld(&bar[XB_XGEN(b.x)]) == gen, bar);
            __builtin_amdgcn_fence(__ATOMIC_ACQUIRE, "agent");
            asm volatile("s_waitcnt vmcnt(0)" ::: "memory");
        }
    }
    __syncthreads();
}

#if MEGA
__global__ void __launch_bounds__(NT, 2) fwd_mega(Params p) {
    extern __shared__ __attribute__((aligned(16))) unsigned char lds_raw[];
    LAS unsigned char* lds = (LAS unsigned char*)lds_raw;
    cg::grid_group grid = cg::this_grid();
    if (threadIdx.x < 4) ((LAS unsigned*)(lds + LDS_CTL))[threadIdx.x] = 0u;
    __syncthreads();
    XcdBarrier bar = xcd_barrier_post((unsigned*)(p.ws + WS_BAR), (volatile LAS unsigned*)(lds + LDS_CTL));
    phase_prologue(p, lds);
    if (p.ws == nullptr) grid.sync();
    xcd_barrier(bar);
    for (int l = 0; l < DEPTH; ++l) {
        phase_gemm1(p, l, lds); xcd_barrier(bar);
        phase_dft(p, lds); phase_xa(p, l, lds); xcd_barrier(bar);
        phase_gemm2(p, l, lds); xcd_barrier(bar);
        phase_gemm3(p, l, lds); xcd_barrier(bar);
        phase_gemm4(p, l, lds); xcd_barrier(bar);
    }
    phase_final(p);
}
#else
template <int PH> __global__ void __launch_bounds__(NT, 2) phase_kernel(Params p, int l) {
    extern __shared__ __attribute__((aligned(16))) unsigned char lds_raw[];
    LAS unsigned char* lds = (LAS unsigned char*)lds_raw;
    if (PH == 0) phase_prologue(p, lds);
    if (PH == 1) phase_gemm1(p, l, lds);
    if (PH == 2) {}
    if (PH == 3) { phase_dft(p, lds); phase_xa(p, l, lds); }
    if (PH == 4) phase_gemm2(p, l, lds);
    if (PH == 5) phase_gemm3(p, l, lds);
    if (PH == 6) phase_gemm4(p, l, lds);
    if (PH == 7) phase_final(p);
}
template <int PH> static void launch_phase(const Params& p, int l, hipStream_t stream) {
    static bool attr = false;
    if (!attr) { (void)hipFuncSetAttribute((const void*)phase_kernel<PH>, hipFuncAttributeMaxDynamicSharedMemorySize, LDS_BYTES); attr = true; }
    hipLaunchKernelGGL(phase_kernel<PH>, dim3(256), dim3(NT), LDS_BYTES, stream, p, l);
}
#endif

extern "C" void kernel_launch(void* const* d_in, const int* in_sizes, int n_in, void* d_out, int out_size, void* d_ws, size_t ws_size, hipStream_t stream) {
    if (n_in != 14 || ws_size < WS_END || out_size != TX * D) { fprintf(stderr, "kernel_launch: unexpected shapes (n_in %d, ws %zu need %zu, out %d)\n", n_in, ws_size, (size_t)WS_END, out_size); return; }
    Params p{};
    p.x_prompt = (const float*)d_in[0]; p.x_sample = (const float*)d_in[1]; p.meta = (const float*)d_in[2]; p.norm1_g = (const float*)d_in[3];
    p.w_in = (const float*)d_in[4]; p.conv_w = (const float*)d_in[5]; p.pool_w = (const float*)d_in[6]; p.pool_scale = (const float*)d_in[7];
    p.mix_g = (const float*)d_in[8]; p.w_out = (const float*)d_in[9]; p.norm2_g = (const float*)d_in[10]; p.w_gate_up = (const float*)d_in[11];
    p.w_down = (const float*)d_in[12]; p.final_g = (const float*)d_in[13];
    p.out = (float*)d_out; p.ws = (unsigned char*)d_ws;
#if MEGA
    static int grid = 0;
    if (grid == 0) {
        int dev = 0, cus = 0, per_cu = 0;
        (void)hipGetDevice(&dev);
        (void)hipDeviceGetAttribute(&cus, hipDeviceAttributeMultiprocessorCount, dev);
        (void)hipFuncSetAttribute((const void*)fwd_mega, hipFuncAttributeMaxDynamicSharedMemorySize, LDS_BYTES);
        (void)hipOccupancyMaxActiveBlocksPerMultiprocessor(&per_cu, (const void*)fwd_mega, NT, LDS_BYTES);
        if (per_cu < 1) per_cu = 1;
        grid = cus * per_cu;
        if (grid > 256) grid = 256;
    }
    (void)hipMemsetAsync((unsigned char*)d_ws + WS_BAR, 0, XCD_BAR_WORDS_C * 4, stream);
    void* args[] = {&p};
    hipError_t e = hipLaunchCooperativeKernel((const void*)fwd_mega, dim3(grid), dim3(NT), args, LDS_BYTES, stream);
    if (e != hipSuccess) fprintf(stderr, "cooperative launch failed: %s (grid %d)\n", hipGetErrorString(e), grid);
#else
    launch_phase<0>(p, 0, stream);
    for (int l = 0; l < DEPTH; ++l) {
        launch_phase<1>(p, l, stream); launch_phase<2>(p, l, stream); launch_phase<3>(p, l, stream);
        launch_phase<4>(p, l, stream); launch_phase<5>(p, l, stream); launch_phase<6>(p, l, stream);
    }
    launch_phase<7>(p, 0, stream);
#endif
}
```
